# Optimizing an MI355X kernel written in HIP

```python
import math
import jax, jax.numpy as jnp
from jax import lax
import numpy as np

D_MODEL = 1024
BATCH = 4
SEQ = 4096
DEPTH = 1

CONV_WIDTH = D_MODEL // 2
CONV_K = 3
DIFF_HEADS = 4
DIFF_HEAD_DIM = 64
DIFF_V_DIM = 2 * DIFF_HEAD_DIM
DIFF_WIDTH = DIFF_HEADS * DIFF_V_DIM
N_BRANCHES = 2
IN_COLS = 3 * CONV_WIDTH + 3 * DIFF_WIDTH + N_BRANCHES * D_MODEL
D_FF = 4 * D_MODEL
Q_BLOCK = 128
RMS_EPS = 1e-6

kernel_name = "hybrid_shortconv_diffattn_gated_merge"


def rmsnorm(x, g):
    xf = x.astype(jnp.float32)
    y = xf * lax.rsqrt(jnp.mean(xf * xf, axis=-1, keepdims=True) + RMS_EPS)
    return (y * g.astype(jnp.float32)).astype(x.dtype)


def alibi_slopes(n_heads):
    return np.array([2.0 ** (-8.0 * (h + 1) / n_heads) for h in range(n_heads)], dtype=np.float32)


def lambda_init_fn(layer_idx):
    return 0.8 - 0.6 * math.exp(-0.3 * layer_idx)


def short_gated_conv(b_gate, c_gate, v, conv_w):
    h = c_gate * v
    hp = jnp.pad(h, ((0, 0), (CONV_K - 1, 0), (0, 0)))
    S = h.shape[1]
    conv = (conv_w[0] * hp[:, 0:S] + conv_w[1] * hp[:, 1:S + 1] + conv_w[2] * hp[:, 2:S + 2])
    return b_gate * conv


def diff_attention(q, k, v, lam, slopes):
    Bsz, S, H = q.shape[0], q.shape[1], q.shape[2]
    nb = S // Q_BLOCK
    scale = DIFF_HEAD_DIM ** -0.5
    q_blocks = q.reshape(Bsz, nb, Q_BLOCK, H, 2, DIFF_HEAD_DIM).transpose(1, 0, 2, 3, 4, 5)
    starts = jnp.arange(nb, dtype=jnp.int32) * Q_BLOCK
    kpos = jnp.arange(S, dtype=jnp.int32)
    slopes_f = jnp.asarray(slopes, dtype=jnp.float32)

    def one_block(args):
        qb, start = args
        s = jnp.einsum('bqhcd,bkhcd->bhcqk', qb, k).astype(jnp.float32) * scale
        qpos = start + jnp.arange(Q_BLOCK, dtype=jnp.int32)
        dist = (qpos[:, None] - kpos[None, :])
        bias = -slopes_f[:, None, None, None] * dist.astype(jnp.float32)[None, None]
        s = jnp.where(dist >= 0, s + bias, -jnp.inf)
        p = jax.nn.softmax(s, axis=-1)
        a = p[:, :, 0] - lam * p[:, :, 1]
        return jnp.einsum('bhqk,bkhv->bqhv', a.astype(v.dtype), v)

    o = lax.map(one_block, (q_blocks, starts))
    return o.transpose(1, 0, 2, 3, 4).reshape(Bsz, S, H, DIFF_V_DIM)


def setup_inputs(seed: int = 0) -> dict:
    key = jax.random.key(seed)
    ks = jax.random.split(key, 20)
    f32 = jnp.float32
    nrm = lambda k, shape, s: (jax.random.normal(k, shape, f32) * s)
    gain = lambda k, shape: 1.0 + 0.05 * jax.random.normal(k, shape, f32)
    return {
        "x": jax.random.normal(ks[0], (BATCH, SEQ, D_MODEL), f32),
        "norm_mix_g": gain(ks[1], (DEPTH, D_MODEL)),
        "w_in": nrm(ks[2], (DEPTH, D_MODEL, IN_COLS), D_MODEL ** -0.5),
        "b_gate": nrm(ks[3], (DEPTH, N_BRANCHES * D_MODEL), 0.02),
        "conv_w": nrm(ks[4], (DEPTH, CONV_K, CONV_WIDTH), CONV_K ** -0.5),
        "lambda_q1": nrm(ks[5], (DEPTH, DIFF_HEAD_DIM), 0.1),
        "lambda_k1": nrm(ks[6], (DEPTH, DIFF_HEAD_DIM), 0.1),
        "lambda_q2": nrm(ks[7], (DEPTH, DIFF_HEAD_DIM), 0.1),
        "lambda_k2": nrm(ks[8], (DEPTH, DIFF_HEAD_DIM), 0.1),
        "subln_g": gain(ks[9], (DEPTH, DIFF_V_DIM)),
        "w_a_out": nrm(ks[10], (DEPTH, CONV_WIDTH, D_MODEL), CONV_WIDTH ** -0.5),
        "w_b_out": nrm(ks[11], (DEPTH, DIFF_WIDTH, D_MODEL), DIFF_WIDTH ** -0.5),
        "w_o": nrm(ks[12], (DEPTH, D_MODEL, D_MODEL), D_MODEL ** -0.5),
        "norm_mlp_g": gain(ks[13], (DEPTH, D_MODEL)),
        "w_mlp_in": nrm(ks[14], (DEPTH, D_MODEL, D_FF), D_MODEL ** -0.5),
        "w_mlp_out": nrm(ks[15], (DEPTH, D_FF, D_MODEL), D_FF ** -0.5),
        "norm_final_g": gain(ks[16], (D_MODEL,)),
    }


def reference(x, norm_mix_g, w_in, b_gate, conv_w, lambda_q1, lambda_k1, lambda_q2, lambda_k2,
              subln_g, w_a_out, w_b_out, w_o, norm_mlp_g, w_mlp_in, w_mlp_out, norm_final_g):
    Bsz, S, _ = x.shape
    slopes = alibi_slopes(DIFF_HEADS)
    c0 = CONV_WIDTH
    q0 = 3 * CONV_WIDTH
    g0 = q0 + 3 * DIFF_WIDTH
    for l in range(DEPTH):
        xn = rmsnorm(x, norm_mix_g[l])
        u = xn @ w_in[l]
        b_g, c_g, v_a = u[..., 0:c0], u[..., c0:2 * c0], u[..., 2 * c0:3 * c0]
        q = u[..., q0:q0 + DIFF_WIDTH].reshape(Bsz, S, DIFF_HEADS, 2, DIFF_HEAD_DIM)
        k = u[..., q0 + DIFF_WIDTH:q0 + 2 * DIFF_WIDTH].reshape(Bsz, S, DIFF_HEADS, 2, DIFF_HEAD_DIM)
        v = u[..., q0 + 2 * DIFF_WIDTH:g0].reshape(Bsz, S, DIFF_HEADS, DIFF_V_DIM)
        gates = jax.nn.sigmoid((u[..., g0:] + b_gate[l]).astype(jnp.float32)).astype(x.dtype)
        g_a, g_b = gates[..., :D_MODEL], gates[..., D_MODEL:]

        y_a = short_gated_conv(b_g, c_g, v_a, conv_w[l]) @ w_a_out[l]

        lam_init = lambda_init_fn(l)
        lam = (jnp.exp(jnp.sum(lambda_q1[l].astype(jnp.float32) * lambda_k1[l].astype(jnp.float32)))
               - jnp.exp(jnp.sum(lambda_q2[l].astype(jnp.float32) * lambda_k2[l].astype(jnp.float32)))
               + lam_init)
        o = diff_attention(q, k, v, lam, slopes)
        o = rmsnorm(o, subln_g[l]) * (1.0 - lam_init)
        y_b = o.reshape(Bsz, S, DIFF_WIDTH) @ w_b_out[l]

        x = x + (g_a * y_a + g_b * y_b) @ w_o[l]

        h = rmsnorm(x, norm_mlp_g[l]) @ w_mlp_in[l]
        x = x + jnp.square(jax.nn.relu(h)) @ w_mlp_out[l]
    return rmsnorm(x, norm_final_g)
```

```cpp
#include <hip/hip_runtime.h>
#include <hip/hip_cooperative_groups.h>
#include <cstdio>
#include <cstdint>
#include <cmath>
namespace cg = cooperative_groups;
namespace pg8 {
#define PG8_LAS __attribute__((address_space(3)))
typedef unsigned short bf16_t;
typedef short bf16x8 __attribute__((ext_vector_type(8)));
typedef float f32x4 __attribute__((ext_vector_type(4)));
typedef unsigned u32x4 __attribute__((ext_vector_type(4)));
constexpr int BM = 256, BK = 64, HALF = 128, HTB = HALF * BK * 2  , STAGE_BYTES = 8 * HTB, NXCD = 8, WGM = 8;

__host__ __device__ __forceinline__ int lds_byte(int r, int c) { const int st = (r >> 4) * 2 + (c >> 5), rr = r & 15, cc = c & 31, ob = rr * 64 + cc * 2; return st * 1024 + (ob ^ (((ob >> 9) & 1) << 5)); }
__host__ __device__ __forceinline__ void stage_rc(int b, int& R, int& C) { const int st = b / 1024, sb = b % 1024, swz = sb ^ (((sb >> 9) & 1) << 5); R = (st >> 1) * 16 + swz / 64; C = (st & 1) * 32 + (swz % 64) / 2; }
__host__ __device__ __forceinline__ int perm32(int rho) { const int n = rho >> 4, i = rho & 15; return 8 * (i >> 2) + 4 * n + (i & 3); }

struct Unit { int pm, pn; };
struct Gemm { const bf16_t* A; const bf16_t* Bt; int M, N, K; };

struct StaticOrder {
    int nM, nN, nwg, G, c;
    __host__ __device__ void init(int M, int N, int G_, int c_) { nM = M / BM; nN = N / BM; nwg = nM * nN; G = G_; c = c_; }
    __host__ __device__ bool next(int i, Unit& u) const {
        const long L = (long)i * G + c; if (L >= nwg) return false;
        int wgid = (int)L; { const int q = nwg / NXCD, r = nwg % NXCD, xcd = wgid % NXCD, off = wgid / NXCD; wgid = (xcd < r ? xcd * (q + 1) : r * (q + 1) + (xcd - r) * q) + off; }
        const int nig = WGM * nN, gid = wgid / nig, fm = gid * WGM, gsz = (nM - fm) < WGM ? (nM - fm) : WGM;
        u.pm = fm + ((wgid % nig) % gsz); u.pn = (wgid % nig) / gsz; return true;
    }
    __device__ __forceinline__ void a_ready(const Unit&) const {}
    __device__ __forceinline__ void done(const Unit&) const {}
};

__device__ __forceinline__ unsigned cvt_pk_bf16(float lo, float hi) { unsigned r; asm volatile("v_cvt_pk_bf16_f32 %0, %1, %2" : "=v"(r) : "v"(lo), "v"(hi)); return r; }
__device__ __forceinline__ float bf_lo(unsigned w) { return __uint_as_float(w << 16); }
__device__ __forceinline__ float bf_hi(unsigned w) { return __uint_as_float(w & 0xffff0000u); }
__device__ __forceinline__ float sigmoidf_fast(float v) { return __builtin_amdgcn_rcpf(1.0f + __builtin_amdgcn_exp2f(-1.4426950408889634f * v)); }

struct EpiIn {
    static constexpr bool PERM = true, AFTER_DRAIN = false, CARRY = false;
    bf16_t* UA; bf16_t* UQ; bf16_t* GT; const float* bgate; float qscale;
    __device__ __forceinline__ void operator()(const f32x4 (&acc)[2][2][4][2], const Unit& u, int wr, int wc, int fr, int fq) const {
        const int row0 = u.pm * BM + wr * 64 + fr; const int ct = u.pn * BM;
        bf16_t* base; int colt, ldc, mode;
        if (ct < 1536) { base = UA; colt = ct; ldc = 1536; mode = 0; }
        else if (ct < 3072) { base = UQ; colt = ct - 1536; ldc = 1536; mode = (ct < 2048) ? 1 : 0; }
        else { base = GT; colt = ct - 3072; ldc = 2048; mode = 2; }
        const int col0 = colt + wc * 32 + 8 * fq;
        f32x4 bv[2][2];
#pragma unroll
        for (int bj = 0; bj < 2; ++bj)
#pragma unroll
            for (int n = 0; n < 2; ++n) bv[bj][n] = (mode == 2) ? *(const f32x4*)(bgate + col0 + bj * HALF + 4 * n) : (f32x4){0.f, 0.f, 0.f, 0.f};
        const float sc = (mode == 1) ? qscale : 1.0f;
#pragma unroll
        for (int ai = 0; ai < 2; ++ai)
#pragma unroll
            for (int m = 0; m < 4; ++m) { bf16_t* rowp = base + (size_t)(row0 + ai * HALF + m * 16) * ldc + col0;
#pragma unroll
                for (int bj = 0; bj < 2; ++bj) { f32x4 v0 = acc[ai][bj][m][0] + bv[bj][0], v1 = acc[ai][bj][m][1] + bv[bj][1];
                    if (mode == 2) {
#pragma unroll
                        for (int e = 0; e < 4; ++e) { v0[e] = sigmoidf_fast(v0[e]); v1[e] = sigmoidf_fast(v1[e]); }
                    }
                    v0 = v0 * sc; v1 = v1 * sc; u32x4 w; w.x = cvt_pk_bf16(v0[0], v0[1]); w.y = cvt_pk_bf16(v0[2], v0[3]); w.z = cvt_pk_bf16(v1[0], v1[1]); w.w = cvt_pk_bf16(v1[2], v1[3]);
                    *(u32x4*)(rowp + bj * HALF) = w; } }
    }
};

template <bool FIRST> struct EpiGate {
    static constexpr bool PERM = true, AFTER_DRAIN = false, CARRY = false;
    const bf16_t* GT; const bf16_t* Tin; bf16_t* O;
    __device__ __forceinline__ void operator()(const f32x4 (&acc)[2][2][4][2], const Unit& u, int wr, int wc, int fr, int fq) const {
        const int row0 = u.pm * BM + wr * 64 + fr; const int col0 = u.pn * BM + wc * 32 + 8 * fq;
#pragma unroll
        for (int ai = 0; ai < 2; ++ai)
#pragma unroll
            for (int m = 0; m < 4; ++m) { const size_t row = (size_t)(row0 + ai * HALF + m * 16);
#pragma unroll
                for (int bj = 0; bj < 2; ++bj) {
                    const u32x4 g = *(const u32x4*)(GT + row * 2048 + (FIRST ? 0 : 1024) + col0 + bj * HALF);
                    f32x4 v0 = acc[ai][bj][m][0], v1 = acc[ai][bj][m][1];
                    v0[0] *= bf_lo(g.x); v0[1] *= bf_hi(g.x); v0[2] *= bf_lo(g.y); v0[3] *= bf_hi(g.y);
                    v1[0] *= bf_lo(g.z); v1[1] *= bf_hi(g.z); v1[2] *= bf_lo(g.w); v1[3] *= bf_hi(g.w);
                    if (!FIRST) { const u32x4 t = *(const u32x4*)(Tin + row * 1024 + col0 + bj * HALF);
                        v0[0] += bf_lo(t.x); v0[1] += bf_hi(t.x); v0[2] += bf_lo(t.y); v0[3] += bf_hi(t.y);
                        v1[0] += bf_lo(t.z); v1[1] += bf_hi(t.z); v1[2] += bf_lo(t.w); v1[3] += bf_hi(t.w); }
                    u32x4 w; w.x = cvt_pk_bf16(v0[0], v0[1]); w.y = cvt_pk_bf16(v0[2], v0[3]); w.z = cvt_pk_bf16(v1[0], v1[1]); w.w = cvt_pk_bf16(v1[2], v1[3]);
                    *(u32x4*)(O + row * 1024 + col0 + bj * HALF) = w; } }
    }
};

template <bool WITH_BF16, bool F32OUT, bool BF16BASE> struct EpiRes {
    static constexpr bool PERM = false, AFTER_DRAIN = false, CARRY = false;
    const float* base; const bf16_t* baseb; float* out; bf16_t* ob; float* rowss;
    __device__ __forceinline__ void operator()(const f32x4 (&acc)[2][2][4][2], const Unit& u, int wr, int wc, int fr, int fq) const {
        typedef unsigned u32x2v __attribute__((ext_vector_type(2)));
        const int row0 = u.pm * BM + wr * 64 + fr; const int col0 = u.pn * BM + wc * 32 + 4 * fq;
#pragma unroll
        for (int ai = 0; ai < 2; ++ai)
#pragma unroll
            for (int m = 0; m < 4; ++m) { const int row = row0 + ai * HALF + m * 16; const size_t off = (size_t)row * 1024 + col0; float ss = 0.f;
#pragma unroll
                for (int bj = 0; bj < 2; ++bj)
#pragma unroll
                    for (int n = 0; n < 2; ++n) { f32x4 bs;
                        if (BF16BASE) { const u32x2v t = *(const u32x2v*)(baseb + off + bj * HALF + n * 16); bs = (f32x4){bf_lo(t.x), bf_hi(t.x), bf_lo(t.y), bf_hi(t.y)}; }
                        else bs = *(const f32x4*)(base + off + bj * HALF + n * 16);
                        const f32x4 v = bs + acc[ai][bj][m][n];
                        if (F32OUT) *(f32x4*)(out + off + bj * HALF + n * 16) = v;
                        ss += (v[0] * v[0] + v[1] * v[1]) + (v[2] * v[2] + v[3] * v[3]);
                        if (WITH_BF16) { u32x2v w; w.x = cvt_pk_bf16(v[0], v[1]); w.y = cvt_pk_bf16(v[2], v[3]); *(u32x2v*)(ob + off + bj * HALF + n * 16) = w; } }
                ss += __shfl_xor(ss, 16); ss += __shfl_xor(ss, 32);
                if (fq == 0) atomicAdd(rowss + row, ss); }
    }
};

struct EpiMlp {
    static constexpr bool PERM = true, AFTER_DRAIN = false, CARRY = false;
    bf16_t* O; const float* rowss; float eps;
    __device__ __forceinline__ void operator()(const f32x4 (&acc)[2][2][4][2], const Unit& u, int wr, int wc, int fr, int fq) const {
        const int row0 = u.pm * BM + wr * 64 + fr; const int col0 = u.pn * BM + wc * 32 + 8 * fq;
#pragma unroll
        for (int ai = 0; ai < 2; ++ai)
#pragma unroll
            for (int m = 0; m < 4; ++m) { const int row = row0 + ai * HALF + m * 16; const float rs = __builtin_amdgcn_rsqf(rowss[row] * (1.0f / 1024.0f) + eps);
                bf16_t* rowp = O + (size_t)row * 4096 + col0;
#pragma unroll
                for (int bj = 0; bj < 2; ++bj) { f32x4 v0 = acc[ai][bj][m][0] * rs, v1 = acc[ai][bj][m][1] * rs;
#pragma unroll
                    for (int e = 0; e < 4; ++e) { const float a = fmaxf(v0[e], 0.f), b = fmaxf(v1[e], 0.f); v0[e] = a * a; v1[e] = b * b; }
                    u32x4 w; w.x = cvt_pk_bf16(v0[0], v0[1]); w.y = cvt_pk_bf16(v0[2], v0[3]); w.z = cvt_pk_bf16(v1[0], v1[1]); w.w = cvt_pk_bf16(v1[2], v1[3]);
                    *(u32x4*)(rowp + bj * HALF) = w; } }
    }
};

struct EpiFinal {
    static constexpr bool PERM = false, AFTER_DRAIN = false, CARRY = false;
    const bf16_t* base; float* out; float* rowss; unsigned* cnt; const float* gfin; float eps;
    __device__ __forceinline__ void operator()(f32x4 (&acc)[2][2][4][2], const Unit& u, int wr, int wc, int fr, int fq) const {
        const int row0 = u.pm * BM + wr * 64 + fr; const int col0 = u.pn * BM + wc * 32 + 4 * fq;
#pragma unroll
        for (int ai = 0; ai < 2; ++ai)
#pragma unroll
            for (int m = 0; m < 4; ++m) { const int row = row0 + ai * HALF + m * 16; const size_t off = (size_t)row * 1024 + col0; float ss = 0.f;
#pragma unroll
                for (int bj = 0; bj < 2; ++bj)
#pragma unroll
                    for (int n = 0; n < 2; ++n) { typedef unsigned u32x2v __attribute__((ext_vector_type(2))); const u32x2v t = *(const u32x2v*)(base + off + bj * HALF + n * 16);
                        const f32x4 v = (f32x4){bf_lo(t.x), bf_hi(t.x), bf_lo(t.y), bf_hi(t.y)} + acc[ai][bj][m][n];
                        acc[ai][bj][m][n] = v; ss += (v[0] * v[0] + v[1] * v[1]) + (v[2] * v[2] + v[3] * v[3]); }
                ss += __shfl_xor(ss, 16); ss += __shfl_xor(ss, 32);
                if (fq == 0) __hip_atomic_store(rowss + (size_t)row * 16 + u.pn * 4 + wc, ss, __ATOMIC_RELAXED, __HIP_MEMORY_SCOPE_AGENT); }
        asm volatile("s_waitcnt vmcnt(0)" ::: "memory");
        unsigned* c = cnt + 64 * u.pm;
        if ((threadIdx.x & 63) == 0) __hip_atomic_fetch_add(c, 1u, __ATOMIC_RELAXED, __HIP_MEMORY_SCOPE_AGENT);
        { unsigned sp = 0;
          while ((unsigned)__builtin_amdgcn_readfirstlane(__hip_atomic_load(c, __ATOMIC_RELAXED, __HIP_MEMORY_SCOPE_AGENT)) < 32u) { __builtin_amdgcn_s_sleep(2); if (++sp > (1u << 22)) break; } }
        asm volatile("" ::: "memory");
#pragma unroll
        for (int ai = 0; ai < 2; ++ai)
#pragma unroll
            for (int m = 0; m < 4; ++m) { const int row = row0 + ai * HALF + m * 16; const size_t off = (size_t)row * 1024 + col0;
                float tot = 0.f;
#pragma unroll
                for (int e = 0; e < 4; ++e) tot += __hip_atomic_load(rowss + (size_t)row * 16 + 4 * fq + e, __ATOMIC_RELAXED, __HIP_MEMORY_SCOPE_AGENT);
                tot += __shfl_xor(tot, 16); tot += __shfl_xor(tot, 32);
                const float rs = __builtin_amdgcn_rsqf(tot * (1.0f / 1024.0f) + eps);
#pragma unroll
                for (int bj = 0; bj < 2; ++bj)
#pragma unroll
                    for (int n = 0; n < 2; ++n) { const f32x4 g = *(const f32x4*)(gfin + col0 + bj * HALF + n * 16);
                        *(f32x4*)(out + off + bj * HALF + n * 16) = acc[ai][bj][m][n] * rs * g; } }
    }
};

struct EpiGatePair {
    static constexpr bool PERM = true, AFTER_DRAIN = false, CARRY = true;
    const bf16_t* GT; bf16_t* O;
    __device__ __forceinline__ void operator()(f32x4 (&acc)[2][2][4][2], const Unit& u, int wr, int wc, int fr, int fq) const {
        const bool second = (u.pm >= 64);
        const int row0 = (u.pm & 63) * BM + wr * 64 + fr; const int col0 = (u.pn & 3) * BM + wc * 32 + 8 * fq;
#pragma unroll
        for (int ai = 0; ai < 2; ++ai)
#pragma unroll
            for (int m = 0; m < 4; ++m) { const size_t row = (size_t)(row0 + ai * HALF + m * 16);
#pragma unroll
                for (int bj = 0; bj < 2; ++bj) {
                    const u32x4 gb = *(const u32x4*)(GT + row * 2048 + 1024 + col0 + bj * HALF);
                    f32x4 v0 = acc[ai][bj][m][0], v1 = acc[ai][bj][m][1];
                    if (!second) {
                        const u32x4 ga = *(const u32x4*)(GT + row * 2048 + col0 + bj * HALF);
                        v0[0] *= bf_lo(ga.x) * __builtin_amdgcn_rcpf(bf_lo(gb.x)); v0[1] *= bf_hi(ga.x) * __builtin_amdgcn_rcpf(bf_hi(gb.x)); v0[2] *= bf_lo(ga.y) * __builtin_amdgcn_rcpf(bf_lo(gb.y)); v0[3] *= bf_hi(ga.y) * __builtin_amdgcn_rcpf(bf_hi(gb.y));
                        v1[0] *= bf_lo(ga.z) * __builtin_amdgcn_rcpf(bf_lo(gb.z)); v1[1] *= bf_hi(ga.z) * __builtin_amdgcn_rcpf(bf_hi(gb.z)); v1[2] *= bf_lo(ga.w) * __builtin_amdgcn_rcpf(bf_lo(gb.w)); v1[3] *= bf_hi(ga.w) * __builtin_amdgcn_rcpf(bf_hi(gb.w));
                        acc[ai][bj][m][0] = v0; acc[ai][bj][m][1] = v1;
                    } else {
                        v0[0] *= bf_lo(gb.x); v0[1] *= bf_hi(gb.x); v0[2] *= bf_lo(gb.y); v0[3] *= bf_hi(gb.y);
                        v1[0] *= bf_lo(gb.z); v1[1] *= bf_hi(gb.z); v1[2] *= bf_lo(gb.w); v1[3] *= bf_hi(gb.w);
                        u32x4 w; w.x = cvt_pk_bf16(v0[0], v0[1]); w.y = cvt_pk_bf16(v0[2], v0[3]); w.z = cvt_pk_bf16(v1[0], v1[1]); w.w = cvt_pk_bf16(v1[2], v1[3]);
                        *(u32x4*)(O + row * 1024 + col0 + bj * HALF) = w;
                        acc[ai][bj][m][0] = (f32x4){0.f, 0.f, 0.f, 0.f}; acc[ai][bj][m][1] = (f32x4){0.f, 0.f, 0.f, 0.f};
                    } } }
    }
};
struct PairOrder {
    StaticOrder so;
    __host__ __device__ void init(int M, int N, int G_, int c_) { so.init(M, N, G_, c_); }
    __host__ __device__ bool next(int i, Unit& u) const { if (!so.next(i >> 1, u)) return false; if (i & 1) { u.pm += 64; u.pn += 4; } return true; }
    __device__ __forceinline__ void a_ready(const Unit&) const {}
    __device__ __forceinline__ void done(const Unit&) const {}
};

template <class Epi, class Sched, bool ALIGN_EPI = false, bool SP2 = false>
__device__ __forceinline__ void gemm_phase(PG8_LAS unsigned char* lds, const Gemm g, const Sched& S, const Epi& E) {
    const int tid = threadIdx.x, wid = __builtin_amdgcn_readfirstlane(tid >> 6), lane = tid & 63, wr = wid >> 2, wc = wid & 3, fr = lane & 15, fq = lane >> 4;
    const int K = g.K, nt = K / BK;
    unsigned voffA[2], voffB[2];
#pragma unroll
    for (int i = 0; i < 2; ++i) { int R, C; stage_rc(tid * 16 + i * 8192, R, C); const int Rb = Epi::PERM ? ((R & ~31) + perm32(R & 31)) : R;
        voffA[i] = (unsigned)(R * K + C) * 2u; voffB[i] = (unsigned)(Rb * K + C) * 2u; }
    const size_t kstep = (size_t)(BK * 2);
    const size_t hstep = (size_t)HALF * K * 2;
    const size_t tstep = 2 * hstep;
    const unsigned ldsw = (unsigned)wid * 1024u;
    const int aoff = lds_byte(wr * 64 + fr, fq * 8), boff = lds_byte(wc * 32 + fr, fq * 8);
#define PG8_SA(b, h) (((b) * 2 + (h)) * HTB)
#define PG8_SB(b, h) ((4 + (b) * 2 + (h)) * HTB)
#define PG8_STAGE(bufoff, gbase, voff) do { _Pragma("unroll") for (int _i = 0; _i < 2; ++_i) \
        __builtin_amdgcn_global_load_lds((const unsigned*)((const char*)(gbase) + (voff)[_i]), (PG8_LAS unsigned*)(lds + (bufoff) + ldsw + _i * 8192), 16, 0, 0); } while (0)
#define PG8_LDA(dst, b, h) do { _Pragma("unroll") for (int m = 0; m < 4; ++m) _Pragma("unroll") for (int k = 0; k < 2; ++k) dst[m][k] = *(const PG8_LAS bf16x8*)(lds + PG8_SA(b, h) + aoff + m * 2048 + k * 1024); } while (0)
#define PG8_LDB(dst, b, h) do { _Pragma("unroll") for (int n = 0; n < 2; ++n) _Pragma("unroll") for (int k = 0; k < 2; ++k) dst[n][k] = *(const PG8_LAS bf16x8*)(lds + PG8_SB(b, h) + boff + n * 2048 + k * 1024); } while (0)
#define PG8_MMA(ai, bj, At, Bt) do { __builtin_amdgcn_s_setprio(1); _Pragma("unroll") for (int m = 0; m < 4; ++m) _Pragma("unroll") for (int n = 0; n < 2; ++n) _Pragma("unroll") for (int k = 0; k < 2; ++k) \
        acc[ai][bj][m][n] = __builtin_amdgcn_mfma_f32_16x16x32_bf16(Bt[n][k], At[m][k], acc[ai][bj][m][n], 0, 0, 0); __builtin_amdgcn_s_setprio(0); } while (0)
#define PG8_WAIT_V(n) asm volatile("s_waitcnt vmcnt(" #n ")" ::: "memory")
#define PG8_WAIT_L(n) asm volatile("s_waitcnt lgkmcnt(" #n ")" ::: "memory")
#define PG8_BAR __builtin_amdgcn_s_barrier()
#define PG8_SCHED __builtin_amdgcn_sched_barrier(0)
    Unit cur, nxt; int ui = 0;
    if (!S.next(0, cur)) return;
    f32x4 acc[2][2][4][2];
#pragma unroll
    for (int a = 0; a < 2; ++a)
#pragma unroll
        for (int b = 0; b < 2; ++b)
#pragma unroll
            for (int m = 0; m < 4; ++m)
#pragma unroll
                for (int n = 0; n < 2; ++n) acc[a][b][m][n] = (f32x4){0.f, 0.f, 0.f, 0.f};
    bf16x8 At[4][2], B0[2][2], B1[2][2];
    const char* cA = (const char*)g.A + (size_t)cur.pm * tstep; const char* cB = (const char*)g.Bt + (size_t)cur.pn * tstep;
    S.a_ready(cur);
    if constexpr (SP2) {
        PG8_STAGE(PG8_SB(0, 0), cB, voffB); PG8_STAGE(PG8_SB(0, 1), cB + hstep, voffB); PG8_STAGE(PG8_SA(0, 0), cA, voffA); PG8_STAGE(PG8_SA(0, 1), cA + hstep, voffA);
        if (wr == 1) PG8_BAR;
        PG8_WAIT_V(2); PG8_BAR;
        PG8_STAGE(PG8_SB(1, 0), cB + kstep, voffB); PG8_STAGE(PG8_SA(1, 0), cA + kstep, voffA); PG8_STAGE(PG8_SB(1, 1), cB + hstep + kstep, voffB);
        PG8_WAIT_V(6); PG8_BAR;
    } else {
        PG8_STAGE(PG8_SB(0, 0), cB, voffB); PG8_STAGE(PG8_SA(0, 0), cA, voffA); PG8_STAGE(PG8_SB(0, 1), cB + hstep, voffB); PG8_STAGE(PG8_SA(0, 1), cA + hstep, voffA);
        if (wr == 1) PG8_BAR;
        PG8_WAIT_V(4); PG8_BAR;
        PG8_STAGE(PG8_SB(1, 0), cB + kstep, voffB); PG8_STAGE(PG8_SA(1, 0), cA + kstep, voffA); PG8_STAGE(PG8_SB(1, 1), cB + hstep + kstep, voffB);
        PG8_WAIT_V(6); PG8_BAR;
    }
    for (;;) {
        const bool has_next = S.next(ui + 1, nxt);
        const char* nA = has_next ? (const char*)g.A + (size_t)nxt.pm * tstep : cA; const char* nB = has_next ? (const char*)g.Bt + (size_t)nxt.pn * tstep : cB;
        for (int t = 0; t < nt; t += 2) {
            const bool last = (t == nt - 2);
            const char* a1 = cA + (size_t)(t + 1) * kstep;
            const char* a2 = last ? nA : cA + (size_t)(t + 2) * kstep; const char* b2 = last ? nB : cB + (size_t)(t + 2) * kstep;
            const char* a3 = a2 + kstep; const char* b3 = b2 + kstep;
            if (last && has_next) S.a_ready(nxt);
            if constexpr (SP2) {
            PG8_LDB(B0, 0, 0); PG8_LDB(B1, 0, 1); PG8_SCHED; PG8_LDA(At, 0, 0); PG8_STAGE(PG8_SA(1, 1), a1 + hstep, voffA);
            PG8_WAIT_V(8); PG8_WAIT_L(0); PG8_BAR; PG8_MMA(0, 0, At, B0); PG8_MMA(0, 1, At, B1); PG8_BAR; PG8_SCHED;
            PG8_LDA(At, 0, 1); PG8_STAGE(PG8_SB(0, 0), b2, voffB); PG8_STAGE(PG8_SB(0, 1), b2 + hstep, voffB); PG8_STAGE(PG8_SA(0, 0), a2, voffA);
            PG8_WAIT_V(8); PG8_WAIT_L(0); PG8_BAR; PG8_MMA(1, 0, At, B0); PG8_MMA(1, 1, At, B1); PG8_BAR; PG8_SCHED;
            PG8_LDB(B0, 1, 0); PG8_LDB(B1, 1, 1); PG8_SCHED; PG8_LDA(At, 1, 0); PG8_STAGE(PG8_SA(0, 1), a2 + hstep, voffA);
            PG8_WAIT_V(8); PG8_WAIT_L(0); PG8_BAR; PG8_MMA(0, 0, At, B0); PG8_MMA(0, 1, At, B1); PG8_BAR; PG8_SCHED;
            PG8_LDA(At, 1, 1); PG8_STAGE(PG8_SB(1, 0), b3, voffB); PG8_STAGE(PG8_SB(1, 1), b3 + hstep, voffB); PG8_STAGE(PG8_SA(1, 0), a3, voffA);
            PG8_WAIT_V(8); PG8_WAIT_L(0); PG8_BAR; PG8_MMA(1, 0, At, B0); PG8_MMA(1, 1, At, B1); PG8_BAR; PG8_SCHED;
            } else {
            PG8_LDB(B0, 0, 0); PG8_SCHED; PG8_LDA(At, 0, 0); PG8_STAGE(PG8_SA(1, 1), a1 + hstep, voffA);
            PG8_WAIT_L(8); PG8_BAR; PG8_WAIT_L(0); PG8_MMA(0, 0, At, B0); PG8_BAR; PG8_SCHED;
            PG8_LDB(B1, 0, 1); PG8_STAGE(PG8_SB(0, 0), b2, voffB);
            PG8_BAR; PG8_WAIT_L(0); PG8_MMA(0, 1, At, B1); PG8_BAR;
            PG8_LDA(At, 0, 1); PG8_STAGE(PG8_SA(0, 0), a2, voffA);
            PG8_BAR; PG8_WAIT_L(0); PG8_MMA(1, 0, At, B0); PG8_BAR; PG8_SCHED;
            PG8_STAGE(PG8_SB(0, 1), b2 + hstep, voffB);
            PG8_WAIT_V(6); PG8_BAR; PG8_MMA(1, 1, At, B1); PG8_BAR;
            PG8_LDB(B0, 1, 0); PG8_SCHED; PG8_LDA(At, 1, 0); PG8_STAGE(PG8_SA(0, 1), a2 + hstep, voffA);
            PG8_WAIT_L(8); PG8_BAR; PG8_WAIT_L(0); PG8_MMA(0, 0, At, B0); PG8_BAR; PG8_SCHED;
            PG8_LDB(B1, 1, 1); PG8_STAGE(PG8_SB(1, 0), b3, voffB);
            PG8_BAR; PG8_WAIT_L(0); PG8_MMA(0, 1, At, B1); PG8_BAR;
            PG8_LDA(At, 1, 1); PG8_STAGE(PG8_SA(1, 0), a3, voffA);
            PG8_BAR; PG8_WAIT_L(0); PG8_MMA(1, 0, At, B0); PG8_BAR; PG8_SCHED;
            PG8_STAGE(PG8_SB(1, 1), b3 + hstep, voffB);
            PG8_WAIT_V(6); PG8_BAR; PG8_MMA(1, 1, At, B1); PG8_BAR;
            }
        }
        if constexpr (ALIGN_EPI) { if (wr == 0) PG8_BAR; }
        if constexpr (!Epi::AFTER_DRAIN) { E(acc, cur, wr, wc, fr, fq); S.done(cur); }
        if (!has_next) break;
        if constexpr (!Epi::CARRY)
#pragma unroll
        for (int a = 0; a < 2; ++a)
#pragma unroll
            for (int b = 0; b < 2; ++b)
#pragma unroll
                for (int m = 0; m < 4; ++m)
#pragma unroll
                    for (int n = 0; n < 2; ++n) acc[a][b][m][n] = (f32x4){0.f, 0.f, 0.f, 0.f};
        cur = nxt; cA = nA; cB = nB; ++ui;
        if constexpr (ALIGN_EPI) { if (wr == 1) PG8_BAR; }
    }
    PG8_WAIT_V(0);
    if constexpr (!ALIGN_EPI) { if (wr == 0) PG8_BAR; }
    PG8_BAR;
    if constexpr (Epi::AFTER_DRAIN) { E.fused(acc, cur, wr, wc, fr, fq, lds, wid, lane); S.done(cur); }
#undef PG8_SA
#undef PG8_SB
#undef PG8_STAGE
#undef PG8_LDA
#undef PG8_LDB
#undef PG8_MMA
#undef PG8_WAIT_V
#undef PG8_WAIT_L
#undef PG8_BAR
#undef PG8_SCHED
}
}

constexpr int NWAVES = 8;
constexpr int BATCH = 4, SEQ = 4096, D = 1024, M = BATCH * SEQ, NIN = 5120, FF = 4096, CW = 512, DW = 512, NH = 4;
constexpr float RMS_EPS = 1e-6f;
constexpr float LOG2E = 1.4426950408889634f;
#ifndef MK_N_LAUNCHES
#define MK_N_LAUNCHES 1
#endif
constexpr int N_PHASES = 8;
#ifndef PROBE_P2_PART
#define PROBE_P2_PART 3
#endif
#ifndef PROBE_DUP_MASK
#define PROBE_DUP_MASK 0
#endif
#define REPS(k) (1 + ((PROBE_DUP_MASK >> (k)) & 1))

constexpr size_t MiB = 1u << 20;
constexpr size_t WS_RSS1 = 0, WS_RSS2 = 65536;
constexpr size_t WS_BAR = 131072, WS_CNT = WS_BAR + 16384, WS_BAR_BYTES = 49152;
constexpr size_t WS_WIN = 1 * MiB;
constexpr size_t WS_WA = 11 * MiB, WS_WB = 12 * MiB;
constexpr size_t WS_WO = 13 * MiB;
constexpr size_t WS_WMI = 15 * MiB;
constexpr size_t WS_WMO = 23 * MiB;
constexpr size_t WS_SLOT = 31 * MiB;
constexpr size_t WS_XN = 32 * MiB;
constexpr size_t WS_UA = 64 * MiB;
constexpr size_t WS_UQ = 112 * MiB;
constexpr size_t WS_GT = 160 * MiB;
constexpr size_t WS_CA = 224 * MiB;
constexpr size_t WS_ON = 240 * MiB;
constexpr size_t WS_MB = 64 * MiB;
constexpr size_t WS_TB = 96 * MiB;
constexpr size_t WS_HB = 64 * MiB;
constexpr size_t WS_END = 256 * MiB;

constexpr int RING_BYTES = 131072;
constexpr int LDS_BYTES = 147456;

#define GAS __attribute__((address_space(1)))
#define LAS __attribute__((address_space(3)))
typedef unsigned short bf16;
typedef unsigned v4u __attribute__((ext_vector_type(4)));
typedef unsigned v2u __attribute__((ext_vector_type(2)));
typedef float f32x4 __attribute__((ext_vector_type(4)));
typedef float f32x16 __attribute__((ext_vector_type(16)));
typedef short bf16x8 __attribute__((ext_vector_type(8)));
typedef short s16x4 __attribute__((ext_vector_type(4)));
#define LDS_WAIT() asm volatile("s_waitcnt lgkmcnt(0)" ::: "memory")
__device__ __forceinline__ unsigned f2bf(float f) { unsigned u = __builtin_bit_cast(unsigned, f); return (u + 0x7fffu + ((u >> 16) & 1u)) >> 16; }
__device__ __forceinline__ unsigned pk2(float lo, float hi) { return f2bf(lo) | (f2bf(hi) << 16); }
__device__ __forceinline__ float bflo(unsigned w) { return __uint_as_float(w << 16); }
__device__ __forceinline__ float bfhi(unsigned w) { return __uint_as_float(w & 0xffff0000u); }
__device__ __forceinline__ float wave_sum(float v) {
#pragma unroll
    for (int o = 1; o < 64; o <<= 1) v += __shfl_xor(v, o);
    return v;
}

__device__ __forceinline__ void p0_transpose_item(const float* W, const float* gain, int K, int N, bf16* WT, LAS float* scr, int item, int lane) {
    const int nblk = N / 32, kb = item / nblk, nb = item % nblk, k0 = 64 * kb, n0 = 32 * nb;
    float wv_[32];
#pragma unroll
    for (int i = 0; i < 32; ++i) { const int kk = 2 * i + (lane >> 5); wv_[i] = W[(size_t)(k0 + kk) * N + n0 + (lane & 31)]; }
    if (gain) {
#pragma unroll
        for (int i = 0; i < 32; ++i) wv_[i] *= gain[k0 + 2 * i + (lane >> 5)];
    }
#pragma unroll
    for (int i = 0; i < 32; ++i) { const int kk = 2 * i + (lane >> 5); scr[kk * 33 + (lane & 31)] = wv_[i]; }
    LDS_WAIT(); asm volatile("" ::: "memory");
    const int c = lane & 7;
#pragma unroll
    for (int j = 0; j < 4; ++j) { const int n = (lane >> 3) + 8 * j; const LAS float* s = scr + (8 * c) * 33 + n;
        v4u o; o.x = pk2(s[0 * 33], s[1 * 33]); o.y = pk2(s[2 * 33], s[3 * 33]); o.z = pk2(s[4 * 33], s[5 * 33]); o.w = pk2(s[6 * 33], s[7 * 33]);
        *(GAS v4u*)(WT + (size_t)(n0 + n) * K + k0 + 8 * c) = o; }
    LDS_WAIT(); asm volatile("" ::: "memory");
}
__device__ __forceinline__ void rms_row_to_bf16(const float* xrow, const float* g, bf16* orow, int lane) {
    const GAS f32x4* xr = (const GAS f32x4*)xrow + lane; const GAS f32x4* gr = (const GAS f32x4*)g + lane;
    f32x4 v[4]; float s2 = 0.f;
#pragma unroll
    for (int j = 0; j < 4; ++j) { v[j] = xr[64 * j]; s2 += (v[j].x * v[j].x + v[j].y * v[j].y) + (v[j].z * v[j].z + v[j].w * v[j].w); }
    const float rstd = 1.f / sqrtf(wave_sum(s2) * (1.f / D) + RMS_EPS);
    GAS unsigned long long* o8 = (GAS unsigned long long*)orow + lane;
#pragma unroll
    for (int j = 0; j < 4; ++j) { const f32x4 gg = gr[64 * j];
        o8[64 * j] = (unsigned long long)pk2(v[j].x * rstd * gg.x, v[j].y * rstd * gg.y) | ((unsigned long long)pk2(v[j].z * rstd * gg.z, v[j].w * rstd * gg.w) << 32); }
}

__device__ __forceinline__ void rms_2rows_to_bf16(const float* xa, const float* xb, const float* g, bf16* oa, bf16* ob, int lane) {
    const GAS f32x4* xra = (const GAS f32x4*)xa + lane; const GAS f32x4* xrb = (const GAS f32x4*)xb + lane; const GAS f32x4* gr = (const GAS f32x4*)g + lane;
    f32x4 va[4], vb[4]; float sa = 0.f, sb = 0.f;
#pragma unroll
    for (int j = 0; j < 4; ++j) { va[j] = xra[64 * j]; vb[j] = xrb[64 * j]; }
#pragma unroll
    for (int j = 0; j < 4; ++j) { sa += (va[j].x * va[j].x + va[j].y * va[j].y) + (va[j].z * va[j].z + va[j].w * va[j].w); sb += (vb[j].x * vb[j].x + vb[j].y * vb[j].y) + (vb[j].z * vb[j].z + vb[j].w * vb[j].w); }
    const float ra = 1.f / sqrtf(wave_sum(sa) * (1.f / D) + RMS_EPS), rb = 1.f / sqrtf(wave_sum(sb) * (1.f / D) + RMS_EPS);
    GAS unsigned long long* o8a = (GAS unsigned long long*)oa + lane; GAS unsigned long long* o8b = (GAS unsigned long long*)ob + lane;
#pragma unroll
    for (int j = 0; j < 4; ++j) { const f32x4 gg = gr[64 * j];
        o8a[64 * j] = (unsigned long long)pk2(va[j].x * ra * gg.x, va[j].y * ra * gg.y) | ((unsigned long long)pk2(va[j].z * ra * gg.z, va[j].w * ra * gg.w) << 32);
        o8b[64 * j] = (unsigned long long)pk2(vb[j].x * rb * gg.x, vb[j].y * rb * gg.y) | ((unsigned long long)pk2(vb[j].z * rb * gg.z, vb[j].w * rb * gg.w) << 32); }
}

namespace att {
constexpr int PITCH = 1536;
constexpr int KROW = 128, VROW = 256;
constexpr int K0_OFF = 0, K1_OFF = 8192, V_OFF = 16384, STAGE = 32768;
static_assert(4 * STAGE <= RING_BYTES, "attention LDS map");
__device__ __forceinline__ void glds16(const void* gsrc, unsigned lds_dst) { unsigned keep;
    asm volatile("s_mov_b32 %0, m0\n\ts_mov_b32 m0, %2\n\ts_nop 0\n\tglobal_load_lds_dwordx4 %1, off\n\ts_mov_b32 m0, %0" : "=&s"(keep) : "v"(gsrc), "s"(lds_dst) : "memory"); }
__device__ __forceinline__ int crow(int r, int hi) { return (r & 3) + 8 * (r >> 2) + 4 * hi; }
__device__ __forceinline__ unsigned cvtpk(float lo, float hi) { unsigned r; asm volatile("v_cvt_pk_bf16_f32 %0, %1, %2" : "=v"(r) : "v"(lo), "v"(hi)); return r; }
__device__ __forceinline__ float max3f(float a, float b, float c) { float r; asm("v_max3_f32 %0, %1, %2, %3" : "=v"(r) : "v"(a), "v"(b), "v"(c)); return r; }
__device__ __forceinline__ s16x4 vtr(LAS const unsigned char* p) { return __builtin_bit_cast(s16x4, __builtin_amdgcn_ds_read_tr16_b64_v4i16((LAS s16x4*)p)); }

__device__ __forceinline__ void unit(int b, int h, int qb, const bf16* UQ, bf16* ON, const float* subg, float lam, LAS unsigned char* lds) {
    const int tid = threadIdx.x, lane = tid & 63, r32 = lane & 31, hi = lane >> 5;
    const int wid = __builtin_amdgcn_readfirstlane(tid >> 6), c = wid >> 2, w = wid & 3;
    const size_t seq0 = (size_t)b * SEQ;
    const int qw0 = 128 * qb + 32 * w, qpos = qw0 + r32;
    const float slope2 = exp2f(-2.0f * (float)(h + 1)) * LOG2E;
    int lanel = lane; asm volatile("" : "+v"(lanel));
    const int krow = 8 * wid + (lanel >> 3), kch = (lanel & 7) ^ ((krow >> 1) & 7);
    const bf16* gk = UQ + (seq0 + krow) * PITCH + 512 + h * 128 + kch * 8;
    const int vrow0 = 8 * wid + (lanel >> 4), vrow1 = vrow0 + 4;
    const int vch0 = (lanel & 15) ^ ((((vrow0 & 3) << 2)) | ((vrow0 >> 2) & 3)), vch1 = (lanel & 15) ^ ((((vrow1 & 3) << 2)) | ((vrow1 >> 2) & 3));
    const bf16* gv0 = UQ + (seq0 + vrow0) * PITCH + 1024 + h * 128 + vch0 * 8;
    const bf16* gv1 = UQ + (seq0 + vrow1) * PITCH + 1024 + h * 128 + vch1 * 8;
    const unsigned ldsb = (unsigned)(size_t)lds;
    const unsigned dk = ldsb + wid * 1024, dv = ldsb + V_OFF + wid * 2048;
#define DMA_TILE(tt) do { const size_t go_ = (size_t)(tt) * 64 * PITCH; const unsigned so_ = (unsigned)(((tt) & 3) * STAGE); \
        glds16(gk + go_, (unsigned)__builtin_amdgcn_readfirstlane(dk + so_ + K0_OFF)); glds16(gk + go_ + 64, (unsigned)__builtin_amdgcn_readfirstlane(dk + so_ + K1_OFF)); \
        glds16(gv0 + go_, (unsigned)__builtin_amdgcn_readfirstlane(dv + so_)); glds16(gv1 + go_, (unsigned)__builtin_amdgcn_readfirstlane(dv + so_ + 1024)); } while (0)
    const int NT = 2 * (qb + 1);
    DMA_TILE(0); DMA_TILE(1); if (NT > 2) DMA_TILE(2);
    LAS const unsigned char* kbase = lds + (c ? K1_OFF : K0_OFF) + r32 * KROW;
    const int kg = (r32 >> 1) & 7;
    int koff[4];
#pragma unroll
    for (int s = 0; s < 4; ++s) koff[s] = (((2 * s + hi) ^ kg) * 16);
    const int gi = lane & 15, vq = gi >> 2, vp = gi & 3, vdh = (lane >> 4) & 1;
    LAS const unsigned char* vb[4][2];
#pragma unroll
    for (int db = 0; db < 4; ++db)
#pragma unroll
        for (int sec = 0; sec < 2; ++sec)
            vb[db][sec] = lds + V_OFF + 256 * (4 * hi + vq) + 16 * ((((db ^ vq) & 3) << 2) | (((2 * vdh + (vp >> 1)) ^ ((hi + 2 * sec) & 3)) & 3)) + 8 * (vp & 1);
    bf16x8 qf[4];
    { const bf16* qp = UQ + (seq0 + qpos) * PITCH + h * 128 + c * 64 + hi * 8;
#pragma unroll
      for (int s = 0; s < 4; ++s) qf[s] = *(const bf16x8*)(qp + 16 * s); }
    asm volatile("" : "+v"(qf[0]), "+v"(qf[1]), "+v"(qf[2]), "+v"(qf[3]));
    f32x16 o[4];
#pragma unroll
    for (int db = 0; db < 4; ++db)
#pragma unroll
        for (int r = 0; r < 16; ++r) o[db][r] = 0.f;
    float mref = 0.f, lrun = 0.f;
    constexpr float THR = 60.0f;
#define VREAD(dst, kk) do { _Pragma("unroll") for (int db_ = 0; db_ < 4; ++db_) { \
        const s16x4 lo_ = vtr(vb[db_][0] + boff + 256 * 16 * (kk)), hh_ = vtr(vb[db_][1] + boff + 256 * (16 * (kk) + 8)); dst[db_] = (bf16x8){lo_[0], lo_[1], lo_[2], lo_[3], hh_[0], hh_[1], hh_[2], hh_[3]}; } } while (0)
#define MMA4(vv, pp) do { _Pragma("unroll") for (int db_ = 0; db_ < 4; ++db_) o[db_] = __builtin_amdgcn_mfma_f32_32x32x16_bf16(vv[db_], pp, o[db_], 0, 0, 0); } while (0)
#define SB() __builtin_amdgcn_sched_barrier(0)
    asm volatile("s_waitcnt vmcnt(0) lgkmcnt(0)\n\ts_barrier" ::: "memory");
    for (int t = 0; t < NT; ++t) {
        const int boff = (t & 3) * STAGE;
        if (t + 3 < NT) DMA_TILE(t + 3);
        const int kt0 = 64 * t;
        if (kt0 <= qw0 + 31) {
            f32x16 p0, p1;
            { const float base0 = fmaf(slope2, (float)(kt0 - qpos + 4 * hi), -mref), base1 = base0 + 32.0f * slope2;
#pragma unroll
              for (int r = 0; r < 16; ++r) { const float cr = (float)((r & 3) + 8 * (r >> 2)); p0[r] = fmaf(slope2, cr, base0); p1[r] = fmaf(slope2, cr, base1); } }
#pragma unroll
            for (int s = 0; s < 4; ++s) {
                const bf16x8 k0f = *(LAS const bf16x8*)(kbase + boff + koff[s]);
                const bf16x8 k1f = *(LAS const bf16x8*)(kbase + boff + 32 * KROW + koff[s]);
                p0 = __builtin_amdgcn_mfma_f32_32x32x16_bf16(k0f, qf[s], p0, 0, 0, 0);
                p1 = __builtin_amdgcn_mfma_f32_32x32x16_bf16(k1f, qf[s], p1, 0, 0, 0);
            }
            bf16x8 vA[4], vB[4];
            VREAD(vA, 0); SB();
            if (kt0 + 63 > qw0) {
#pragma unroll
                for (int r = 0; r < 16; ++r) { const int kv = kt0 + crow(r, hi); if (kv > qpos) p0[r] = -INFINITY; if (kv + 32 > qpos) p1[r] = -INFINITY; }
            }
            asm volatile("s_nop 15\n\ts_nop 3" : "+v"(p0), "+v"(p1));
            float mx = max3f(p0[0], p1[0], p0[1]), mx2 = max3f(p1[1], p0[2], p1[2]);
#pragma unroll
            for (int r = 3; r < 15; r += 2) { mx = max3f(mx, p0[r], p1[r]); mx2 = max3f(mx2, p0[r + 1], p1[r + 1]); }
            mx = max3f(mx, p0[15], p1[15]);
            mx = max3f(mx, mx2, __shfl_xor(fmaxf(mx, mx2), 32));
            if (t == 0 || __any(mx > THR)) {
                const float dl = (t == 0) ? mx : fmaxf(mx, 0.f);
                mref += dl;
                const float f = (t == 0) ? 1.0f : __builtin_amdgcn_exp2f(-dl);
                lrun *= f;
#pragma unroll
                for (int r = 0; r < 16; ++r) { p0[r] -= dl; p1[r] -= dl; }
#pragma unroll
                for (int db = 0; db < 4; ++db)
#pragma unroll
                    for (int r = 0; r < 16; ++r) o[db][r] *= f;
            }
            float ls = 0.f;
#pragma unroll
            for (int r = 0; r < 16; ++r) { p0[r] = __builtin_amdgcn_exp2f(p0[r]); p1[r] = __builtin_amdgcn_exp2f(p1[r]); ls += p0[r] + p1[r]; }
            lrun += ls;
            bf16x8 pa[4];
            { v4u x;
              x.x = cvtpk(p0[0], p0[1]); x.y = cvtpk(p0[2], p0[3]); x.z = cvtpk(p0[4], p0[5]); x.w = cvtpk(p0[6], p0[7]); pa[0] = __builtin_bit_cast(bf16x8, x);
              x.x = cvtpk(p0[8], p0[9]); x.y = cvtpk(p0[10], p0[11]); x.z = cvtpk(p0[12], p0[13]); x.w = cvtpk(p0[14], p0[15]); pa[1] = __builtin_bit_cast(bf16x8, x);
              x.x = cvtpk(p1[0], p1[1]); x.y = cvtpk(p1[2], p1[3]); x.z = cvtpk(p1[4], p1[5]); x.w = cvtpk(p1[6], p1[7]); pa[2] = __builtin_bit_cast(bf16x8, x);
              x.x = cvtpk(p1[8], p1[9]); x.y = cvtpk(p1[10], p1[11]); x.z = cvtpk(p1[12], p1[13]); x.w = cvtpk(p1[14], p1[15]); pa[3] = __builtin_bit_cast(bf16x8, x); }
            SB(); VREAD(vB, 1); SB(); MMA4(vA, pa[0]);
            SB(); VREAD(vA, 2); SB(); MMA4(vB, pa[1]);
            SB(); VREAD(vB, 3); SB(); MMA4(vA, pa[2]);
            SB(); MMA4(vB, pa[3]); SB();
        }
        if (t + 3 < NT) asm volatile("s_waitcnt vmcnt(8) lgkmcnt(0)\n\ts_barrier" ::: "memory");
        else if (t + 2 < NT) asm volatile("s_waitcnt vmcnt(4) lgkmcnt(0)\n\ts_barrier" ::: "memory");
        else asm volatile("s_waitcnt vmcnt(0) lgkmcnt(0)\n\ts_barrier" ::: "memory");
    }
#undef DMA_TILE
#undef VREAD
#undef MMA4
#undef SB
    lrun += __shfl_xor(lrun, 32);
    const float inv = 1.0f / lrun;
    LAS float* X = (LAS float*)lds;
    if (c == 1) {
        const float sc = inv * lam;
#pragma unroll
        for (int db = 0; db < 4; ++db)
#pragma unroll
            for (int r = 0; r < 16; ++r) X[(w * 64 + db * 16 + r) * 64 + lane] = o[db][r] * sc;
    }
    __syncthreads();
    if (c == 0) {
        float ss = 0.f;
#pragma unroll
        for (int db = 0; db < 4; ++db)
#pragma unroll
            for (int r = 0; r < 16; ++r) { const float d = o[db][r] * inv - X[(w * 64 + db * 16 + r) * 64 + lane]; o[db][r] = d; ss += d * d; }
        ss += __shfl_xor(ss, 32);
        const float rs = 0.8f / sqrtf(ss * (1.0f / 128.0f) + RMS_EPS);
        bf16* orow = ON + (seq0 + qpos) * DW + h * 128;
        f32x4 gsub[4][4];
#pragma unroll
        for (int db = 0; db < 4; ++db)
#pragma unroll
            for (int rg = 0; rg < 4; ++rg) gsub[db][rg] = *(const f32x4*)(subg + 32 * db + 8 * rg + 4 * hi);
        asm volatile("" ::: "memory");
#pragma unroll
        for (int db = 0; db < 4; ++db)
#pragma unroll
            for (int rg = 0; rg < 4; ++rg) { const int d0 = 32 * db + 8 * rg + 4 * hi; const f32x4 g = gsub[db][rg];
                v2u wv2; wv2.x = pk2(o[db][4 * rg] * rs * g.x, o[db][4 * rg + 1] * rs * g.y); wv2.y = pk2(o[db][4 * rg + 2] * rs * g.z, o[db][4 * rg + 3] * rs * g.w);
                *(v2u*)(orow + d0) = wv2; }
    }
    __syncthreads();
}
}

#define XB_TMO      128
#define XB_XCNT(j)  (256  + 64 * (j))
#define XB_XSUB(j)  (1280 + 64 * (j))
#define XB_XGEN(j)  (2304 + 64 * (j))
#define XB_TOP      3328
#define XB_TOPGEN   3392
#define XCD_BAR_WORDS 3456
#define XB_SPIN_CAP (1u << 18)

__device__ __forceinline__ unsigned xb_ld(unsigned* p)              { return __hip_atomic_load(p, __ATOMIC_RELAXED, __HIP_MEMORY_SCOPE_AGENT); }
__device__ __forceinline__ unsigned xb_add(unsigned* p, unsigned v) { return __hip_atomic_fetch_add(p, v, __ATOMIC_RELAXED, __HIP_MEMORY_SCOPE_AGENT); }
__device__ __forceinline__ unsigned xb_xcc_id() { return (unsigned)__builtin_amdgcn_s_getreg((3 << 11) | 20) & 0xFu; }
#define XB_SPIN(cond, bar) do { unsigned _sp = 0; while (cond) { __builtin_amdgcn_s_sleep(1); \
    if ((++_sp & 255u) == 0u) { if (xb_ld(&(bar)[XB_TMO])) break; if (_sp > XB_SPIN_CAP) { atomicAdd(&(bar)[XB_TMO], 1u); break; } } } } while (0)

struct XcdBarrier {
    unsigned* bar; unsigned x;
    volatile LAS unsigned* st;
};

__device__ __forceinline__ XcdBarrier xcd_barrier_post(unsigned* bar, volatile LAS unsigned* st) {
    XcdBarrier b; b.bar = bar; b.x = xb_xcc_id(); b.st = st;
    if (threadIdx.x == 0) (void)xb_add(&bar[XB_XCNT(b.x)], 1u);
    return b;
}
__device__ __forceinline__ void xcd_barrier_complete(unsigned* bar, unsigned x, unsigned& nloc, unsigned& nx) {
    const unsigned G = gridDim.x * gridDim.y * gridDim.z;
    unsigned sum, cnt, mine, sp = 0u;
    for (;;) {
        sum = 0u; cnt = 0u; mine = 0u;
#pragma unroll
        for (unsigned j = 0; j < 16; ++j) { const unsigned c = xb_ld(&bar[XB_XCNT(j)]); sum += c; cnt += (c > 0u) ? 1u : 0u; mine = (j == x) ? c : mine; }
        if (sum == G) break;
        __builtin_amdgcn_s_sleep(1);
        if ((++sp & 255u) == 0u) { if (xb_ld(&bar[XB_TMO])) break; if (sp > XB_SPIN_CAP) { atomicAdd(&bar[XB_TMO], 1u); break; } }
    }
    nloc = mine > 0u ? mine : 1u; nx = cnt > 0u ? cnt : 1u;
}

__device__ __forceinline__ void xcd_barrier(const XcdBarrier& b) {
    asm volatile("s_waitcnt vmcnt(0)" ::: "memory");
    __syncthreads();
    if (threadIdx.x == 0) {
        unsigned* bar = b.bar;
        __builtin_amdgcn_s_waitcnt(0);
        unsigned nloc = b.st[0], nx = b.st[1];
        if (nloc == 0u) { xcd_barrier_complete(bar, b.x, nloc, nx); b.st[0] = nloc; b.st[1] = nx; }
        const unsigned old = xb_add(&bar[XB_XSUB(b.x)], 1u);
        const unsigned gen = old / nloc;
        if (old + 1u == (gen + 1u) * nloc) {
            __builtin_amdgcn_fence(__ATOMIC_RELEASE, "agent");
            asm volatile("s_waitcnt vmcnt(0)" ::: "memory");
            const unsigned og = xb_add(&bar[XB_TOP], 1u);
            const unsigned tg = og / nx;
            if (og + 1u == (tg + 1u) * nx) xb_add(&bar[XB_TOPGEN], 1u);
            else XB_SPIN(xb_ld(&bar[XB_TOPGEN]) == tg, bar);
            __builtin_amdgcn_fence(__ATOMIC_ACQUIRE, "agent");
            xb_add(&bar[XB_XGEN(b.x)], 1u);
            asm volatile("s_waitcnt vmcnt(0)" ::: "memory");
        } else {
            XB_SPIN(xb_ld(&bar[XB_XGEN(b.x)]) == gen, bar);
            __builtin_amdgcn_fence(__ATOMIC_ACQUIRE, "agent");
            asm volatile("s_waitcnt vmcnt(0)" ::: "memory");
        }
    }
    __syncthreads();
}

struct Args { const float* in[17]; float* out; unsigned char* ws; int ph_lo, ph_hi; };
static_assert(sizeof(Args) == 17 * 8 + 8 + 8 + 8, "Args has no padding");

__global__ void __launch_bounds__(NWAVES * 64, 2) fwd_kernel(Args args) {
    extern __shared__ __attribute__((aligned(16))) unsigned char lds_raw[];
    LAS unsigned char* lds = (LAS unsigned char*)lds_raw;
    cg::grid_group grid = cg::this_grid();
    const int tid = threadIdx.x, lane = tid & 63, wave = __builtin_amdgcn_readfirstlane(tid >> 6);
    const int G = gridDim.x, bx = blockIdx.x;
    const int vcu = (G % 8 == 0) ? (bx % 8) * (G / 8) + bx / 8 : bx;
    unsigned char* ws = args.ws;
    const float* x = args.in[0]; const float* norm_mix_g = args.in[1]; const float* w_in = args.in[2]; const float* b_gate = args.in[3]; const float* conv_w = args.in[4];
    const float* lq1 = args.in[5]; const float* lk1 = args.in[6]; const float* lq2 = args.in[7]; const float* lk2 = args.in[8]; const float* subln_g = args.in[9];
    const float* w_a_out = args.in[10]; const float* w_b_out = args.in[11]; const float* w_o = args.in[12]; const float* norm_mlp_g = args.in[13];
    const float* w_mlp_in = args.in[14]; const float* w_mlp_out = args.in[15]; const float* norm_final_g = args.in[16];
    float* out = args.out;
    float* rss1 = (float*)(ws + WS_RSS1); float* rss2 = (float*)(ws + WS_RSS2);
    bf16 *Win = (bf16*)(ws + WS_WIN), *Wa = (bf16*)(ws + WS_WA), *Wb = (bf16*)(ws + WS_WB), *Wo = (bf16*)(ws + WS_WO), *Wmi = (bf16*)(ws + WS_WMI), *Wmo = (bf16*)(ws + WS_WMO);
    bf16 *XN = (bf16*)(ws + WS_XN), *UA = (bf16*)(ws + WS_UA), *UQ = (bf16*)(ws + WS_UQ), *GT = (bf16*)(ws + WS_GT), *CA = (bf16*)(ws + WS_CA), *ON = (bf16*)(ws + WS_ON);
    bf16 *MB = (bf16*)(ws + WS_MB), *TB = (bf16*)(ws + WS_TB), *HB = (bf16*)(ws + WS_HB);
    const int lo = args.ph_lo, hi = args.ph_hi;
    volatile LAS unsigned* MISC = (volatile LAS unsigned*)(lds + RING_BYTES + 512);
    if (tid < 2) MISC[tid] = 0u;
    __syncthreads();
    if (args.ph_lo < 0) grid.sync();
    const XcdBarrier bar = xcd_barrier_post((unsigned*)(ws + WS_BAR), MISC);
#define IN(k) (lo <= (k) && (k) < hi)
#define SEAM(k) do { if (IN(k) && IN((k) + 1)) { xcd_barrier(bar); } } while (0)

    if (IN(0)) _Pragma("unroll") for (int rep_ = 0; rep_ < REPS(0); ++rep_) {
        if (rep_) grid.sync();
        LAS float* scr = (LAS float*)(lds + wave * 16384);
        const int gw = vcu * NWAVES + wave, NGW = G * NWAVES;
        constexpr int I_IN = (D / 64) * (NIN / 32), I_A = (CW / 64) * (D / 32), I_B = I_A, I_O = (D / 64) * (D / 32), I_MI = (D / 64) * (FF / 32), I_MO = (FF / 64) * (D / 32);
        constexpr int NITEMS = I_IN + I_A + I_B + I_O + I_MI + I_MO;
        for (int it = gw; it < NITEMS; it += NGW) {
            int r = it;
            if (r < I_IN) { p0_transpose_item(w_in, nullptr, D, NIN, Win, scr, r, lane); continue; } r -= I_IN;
            if (r < I_A) { p0_transpose_item(w_a_out, nullptr, CW, D, Wa, scr, r, lane); continue; } r -= I_A;
            if (r < I_B) { p0_transpose_item(w_b_out, nullptr, DW, D, Wb, scr, r, lane); continue; } r -= I_B;
            if (r < I_O) { p0_transpose_item(w_o, nullptr, D, D, Wo, scr, r, lane); continue; } r -= I_O;
            if (r < I_MI) { p0_transpose_item(w_mlp_in, norm_mlp_g, D, FF, Wmi, scr, r, lane); continue; } r -= I_MI;
            p0_transpose_item(w_mlp_out, nullptr, FF, D, Wmo, scr, r, lane);
        }
        for (int m = gw; m < M; m += 2 * NGW) {
            if (m + NGW < M) rms_2rows_to_bf16(x + (size_t)m * D, x + (size_t)(m + NGW) * D, norm_mix_g, XN + (size_t)m * D, XN + (size_t)(m + NGW) * D, lane);
            else rms_row_to_bf16(x + (size_t)m * D, norm_mix_g, XN + (size_t)m * D, lane);
        }
        for (int i = bx * (NWAVES * 64) + tid; i < M; i += G * NWAVES * 64) { rss1[i] = 0.f; rss2[i] = 0.f; }
    }
    SEAM(0);

    if (IN(1)) _Pragma("unroll") for (int rep_ = 0; rep_ < REPS(1); ++rep_) {
        if (rep_) grid.sync();
        pg8::Gemm g{XN, Win, M, NIN, D}; pg8::StaticOrder S; S.init(M, NIN, G, bx);
        pg8::EpiIn E{UA, UQ, GT, b_gate, 0.125f * LOG2E};
        pg8::gemm_phase<pg8::EpiIn, pg8::StaticOrder, true, true>(lds, g, S, E);
    }
    SEAM(1);

    if (IN(2)) _Pragma("unroll") for (int rep_ = 0; rep_ < REPS(2); ++rep_) {
        if (rep_) grid.sync();
        float lam;
        { const float a = wave_sum(lq1[lane] * lk1[lane]), b2 = wave_sum(lq2[lane] * lk2[lane]); lam = expf(a) - expf(b2) + 0.2f; }
        if (rep_ == 0 || (PROBE_P2_PART & 1)) for (int p = vcu; p < 256; p += G) {
            const int bh = p >> 4, s = p & 15;
            att::unit(bh >> 2, bh & 3, 31 - s, UQ, ON, subln_g, lam, lds);
            att::unit(bh >> 2, bh & 3, s, UQ, ON, subln_g, lam, lds);
        }
        if (rep_ == 0 || (PROBE_P2_PART & 2)) for (int grp = (bx * (NWAVES * 64) + tid) >> 6; grp < M / 8; grp += (G * NWAVES * 64) >> 6) {
            const int t0 = grp * 8, ch = (tid & 63) * 8, ts0 = t0 & (SEQ - 1);
            const bf16* row = UA + (size_t)t0 * 1536 + ch;
            f32x4 wa[3], wb[3];
#pragma unroll
            for (int k = 0; k < 3; ++k) { wa[k] = *(const f32x4*)(conv_w + k * 512 + ch); wb[k] = *(const f32x4*)(conv_w + k * 512 + ch + 4); }
            v4u bgv[8], cgv[10], vav[10];
            cgv[0] = cgv[1] = vav[0] = vav[1] = (v4u){0, 0, 0, 0};
            if (ts0 != 0) { cgv[0] = *(const v4u*)(row - 3072 + 512); vav[0] = *(const v4u*)(row - 3072 + 1024); cgv[1] = *(const v4u*)(row - 1536 + 512); vav[1] = *(const v4u*)(row - 1536 + 1024); }
#pragma unroll
            for (int j = 0; j < 8; ++j) { bgv[j] = *(const v4u*)(row + j * 1536); cgv[j + 2] = *(const v4u*)(row + j * 1536 + 512); vav[j + 2] = *(const v4u*)(row + j * 1536 + 1024); }
            float hl[10][8];
#pragma unroll
            for (int j = 0; j < 10; ++j)
#pragma unroll
                for (int e = 0; e < 4; ++e) { hl[j][2 * e] = bflo(cgv[j][e]) * bflo(vav[j][e]); hl[j][2 * e + 1] = bfhi(cgv[j][e]) * bfhi(vav[j][e]); }
#pragma unroll
            for (int j = 0; j < 8; ++j) { v4u ov;
#pragma unroll
                for (int e = 0; e < 4; ++e) {
                    const float w0l = (e < 2) ? wa[0][2 * e] : wb[0][2 * e - 4], w0h = (e < 2) ? wa[0][2 * e + 1] : wb[0][2 * e - 3];
                    const float w1l = (e < 2) ? wa[1][2 * e] : wb[1][2 * e - 4], w1h = (e < 2) ? wa[1][2 * e + 1] : wb[1][2 * e - 3];
                    const float w2l = (e < 2) ? wa[2][2 * e] : wb[2][2 * e - 4], w2h = (e < 2) ? wa[2][2 * e + 1] : wb[2][2 * e - 3];
                    const float lo_ = bflo(bgv[j][e]) * (w0l * hl[j][2 * e] + w1l * hl[j + 1][2 * e] + w2l * hl[j + 2][2 * e]);
                    const float hi_ = bfhi(bgv[j][e]) * (w0h * hl[j][2 * e + 1] + w1h * hl[j + 1][2 * e + 1] + w2h * hl[j + 2][2 * e + 1]);
                    ov[e] = pk2(lo_, hi_); }
                *(v4u*)(CA + (size_t)(t0 + j) * CW + ch) = ov; }
        }
    }
    SEAM(2);

    if (IN(3)) {
        static_assert(WS_ON == WS_CA + (size_t)M * CW * 2 && WS_WB == WS_WA + (size_t)D * CW * 2, "P3 needs CA|ON and Wa|Wb stacked");
        pg8::Gemm g{CA, Wa, 2 * M, 2 * D, CW}; pg8::PairOrder S; S.init(M, D, G, bx);
        pg8::EpiGatePair E{GT, MB};
        pg8::gemm_phase<pg8::EpiGatePair, pg8::PairOrder, true, true>(lds, g, S, E);
    }
    SEAM(3);

    if (IN(4)) {
        pg8::Gemm g{MB, Wo, M, D, D}; pg8::StaticOrder S; S.init(M, D, G, bx);
        pg8::EpiRes<true, false, false> E{x, nullptr, nullptr, XN, rss1};
        pg8::gemm_phase<pg8::EpiRes<true, false, false>, pg8::StaticOrder, true, true>(lds, g, S, E);
    }
    SEAM(4);

    if (IN(5)) _Pragma("unroll") for (int rep_ = 0; rep_ < REPS(5); ++rep_) {
        if (rep_) grid.sync();
        pg8::Gemm g{XN, Wmi, M, FF, D}; pg8::StaticOrder S; S.init(M, FF, G, bx);
        pg8::EpiMlp E{HB, rss1, RMS_EPS};
        pg8::gemm_phase<pg8::EpiMlp, pg8::StaticOrder, true, true>(lds, g, S, E);
    }
    SEAM(5);

    const bool fuse_final = (G == 256) && IN(6) && IN(7);
    if (IN(6)) {
        pg8::Gemm g{HB, Wmo, M, D, FF}; pg8::StaticOrder S; S.init(M, D, G, bx);
        if (fuse_final) { pg8::EpiFinal E{XN, out, (float*)(ws + WS_SLOT), (unsigned*)(ws + WS_CNT), norm_final_g, RMS_EPS}; pg8::gemm_phase<pg8::EpiFinal, pg8::StaticOrder, true, true>(lds, g, S, E); }
        else { pg8::EpiRes<false, true, true> E{nullptr, XN, out, nullptr, rss2}; pg8::gemm_phase<pg8::EpiRes<false, true, true>, pg8::StaticOrder, true, true>(lds, g, S, E); }
    }
    if (!fuse_final) {
    SEAM(6);

    if (IN(7)) {
        const int gw = bx * NWAVES + wave, NGW = G * NWAVES;
        for (int m = gw; m < M; m += NGW) {
            const float rs = 1.0f / sqrtf(rss2[m] * (1.0f / D) + RMS_EPS);
            GAS f32x4* o = (GAS f32x4*)(out + (size_t)m * D) + lane; const GAS f32x4* gr = (const GAS f32x4*)norm_final_g + lane;
#pragma unroll
            for (int j = 0; j < 4; ++j) { const f32x4 v = o[64 * j], gg = gr[64 * j]; o[64 * j] = v * rs * gg; }
        }
    }
    }
#undef IN
#undef SEAM
}

extern "C" void kernel_launch(void* const* d_in, const int* in_sizes, int n_in, void* d_out, int out_size, void* d_ws, size_t ws_size, hipStream_t stream) {
    static int grid = 0;
    if (grid == 0) {
        if (n_in != 17 || out_size != M * D || ws_size < WS_END) { fprintf(stderr, "kernel_launch: unexpected shapes (n_in %d out %d ws %zu)\n", n_in, out_size, ws_size); grid = -1; return; }
        int dev = 0, cus = 0, per_cu = 0;
        if (hipGetDevice(&dev) != hipSuccess || hipDeviceGetAttribute(&cus, hipDeviceAttributeMultiprocessorCount, dev) != hipSuccess) { grid = -1; return; }
        if (hipFuncSetAttribute((const void*)fwd_kernel, hipFuncAttributeMaxDynamicSharedMemorySize, LDS_BYTES) != hipSuccess) { fprintf(stderr, "kernel_launch: hipFuncSetAttribute failed\n"); grid = -1; return; }
        if (hipOccupancyMaxActiveBlocksPerMultiprocessor(&per_cu, (const void*)fwd_kernel, NWAVES * 64, LDS_BYTES) != hipSuccess || per_cu < 1) per_cu = 1;
        (void)hipGetLastError();
        grid = cus * per_cu;
    }
    if (grid < 0) return;
    Args a{};
    for (int i = 0; i < 17; ++i) a.in[i] = (const float*)d_in[i];
    a.out = (float*)d_out; a.ws = (unsigned char*)d_ws;
#if MK_N_LAUNCHES == 1
    if (hipMemsetAsync((char*)d_ws + WS_BAR, 0, WS_BAR_BYTES, stream) != hipSuccess) { fprintf(stderr, "kernel_launch: memset of the barrier words failed\n"); return; }
    a.ph_lo = 0; a.ph_hi = N_PHASES;
    void* kargs[] = {&a};
    hipError_t e = hipLaunchCooperativeKernel((const void*)fwd_kernel, dim3(grid), dim3(NWAVES * 64), kargs, LDS_BYTES, stream);
    if (e != hipSuccess) fprintf(stderr, "kernel_launch: cooperative launch failed: %s (grid %d)\n", hipGetErrorString(e), grid);
#else
    for (int p = 0; p < N_PHASES; ++p) {
        a.ph_lo = p; a.ph_hi = p + 1;
        hipLaunchKernelGGL(fwd_kernel, dim3(grid), dim3(NWAVES * 64), LDS_BYTES, stream, a);
    }
#endif
}
```

```cpp
#include <hip/hip_runtime.h>
#include <hip/hip_cooperative_groups.h>
#include <cstdio>
#include <cstdint>
#include <cmath>
namespace cg = cooperative_groups;
namespace pg8 {
#define PG8_LAS __attribute__((address_space(3)))
typedef unsigned short bf16_t;
typedef short bf16x8 __attribute__((ext_vector_type(8)));
typedef float f32x4 __attribute__((ext_vector_type(4)));
typedef unsigned u32x4 __attribute__((ext_vector_type(4)));
constexpr int BM = 256, BK = 64, HALF = 128, HTB = HALF * BK * 2  , STAGE_BYTES = 8 * HTB, NXCD = 8, WGM = 8;

__host__ __device__ __forceinline__ int lds_byte(int r, int c) { const int st = (r >> 4) * 2 + (c >> 5), rr = r & 15, cc = c & 31, ob = rr * 64 + cc * 2; return st * 1024 + (ob ^ (((ob >> 9) & 1) << 5)); }
__host__ __device__ __forceinline__ void stage_rc(int b, int& R, int& C) { const int st = b / 1024, sb = b % 1024, swz = sb ^ (((sb >> 9) & 1) << 5); R = (st >> 1) * 16 + swz / 64; C = (st & 1) * 32 + (swz % 64) / 2; }
__host__ __device__ __forceinline__ int perm32(int rho) { const int n = rho >> 4, i = rho & 15; return 8 * (i >> 2) + 4 * n + (i & 3); }

struct Unit { int pm, pn; };
struct Gemm { const bf16_t* A; const bf16_t* Bt; int M, N, K; };

struct StaticOrder {
    int nM, nN, nwg, G, c;
    __host__ __device__ void init(int M, int N, int G_, int c_) { nM = M / BM; nN = N / BM; nwg = nM * nN; G = G_; c = c_; }
    __host__ __device__ bool next(int i, Unit& u) const {
        const long L = (long)i * G + c; if (L >= nwg) return false;
        int wgid = (int)L; { const int q = nwg / NXCD, r = nwg % NXCD, xcd = wgid % NXCD, off = wgid / NXCD; wgid = (xcd < r ? xcd * (q + 1) : r * (q + 1) + (xcd - r) * q) + off; }
        const int nig = WGM * nN, gid = wgid / nig, fm = gid * WGM, gsz = (nM - fm) < WGM ? (nM - fm) : WGM;
        u.pm = fm + ((wgid % nig) % gsz); u.pn = (wgid % nig) / gsz; return true;
    }
    __device__ __forceinline__ void a_ready(const Unit&) const {}
    __device__ __forceinline__ void done(const Unit&) const {}
};

__device__ __forceinline__ unsigned cvt_pk_bf16(float lo, float hi) { unsigned r; asm volatile("v_cvt_pk_bf16_f32 %0, %1, %2" : "=v"(r) : "v"(lo), "v"(hi)); return r; }
__device__ __forceinline__ float bf_lo(unsigned w) { return __uint_as_float(w << 16); }
__device__ __forceinline__ float bf_hi(unsigned w) { return __uint_as_float(w & 0xffff0000u); }
__device__ __forceinline__ float sigmoidf_fast(float v) { return __builtin_amdgcn_rcpf(1.0f + __builtin_amdgcn_exp2f(-1.4426950408889634f * v)); }


__device__ __forceinline__ u32x4 xpose16(u32x4 w, int srcaddr) {
    u32x4 r;
    r.x = (unsigned)__builtin_amdgcn_ds_bpermute(srcaddr, (int)w.x); r.y = (unsigned)__builtin_amdgcn_ds_bpermute(srcaddr, (int)w.y);
    r.z = (unsigned)__builtin_amdgcn_ds_bpermute(srcaddr, (int)w.z); r.w = (unsigned)__builtin_amdgcn_ds_bpermute(srcaddr, (int)w.w);
    return r;
}

struct EpiIn {
    static constexpr bool PERM = true, AFTER_DRAIN = false, CARRY = false;
    bf16_t* UA; bf16_t* UQ; bf16_t* GT; const float* bgate; float qscale;
    __device__ __forceinline__ void operator()(const f32x4 (&acc)[2][2][4][2], const Unit& u, int wr, int wc, int fr, int fq) const {
        const int row0 = u.pm * BM + wr * 64 + fr; const int ct = u.pn * BM;
        bf16_t* base; int colt, ldc, mode;
        if (ct < 1536) { base = UA; colt = ct; ldc = 1536; mode = 0; }
        else if (ct < 3072) { base = UQ; colt = ct - 1536; ldc = 1536; mode = (ct < 2048) ? 1 : 0; }
        else { base = GT; colt = ct - 3072; ldc = 2048; mode = 2; }
        const int col0 = colt + wc * 32 + 8 * fq;
        const int ln = threadIdx.x & 63, sfr = ln >> 2, sfq = ln & 3, srca = (sfr + 16 * sfq) * 4;
        const int srow0 = u.pm * BM + wr * 64 + sfr, scol0 = colt + wc * 32 + 8 * sfq;
        f32x4 bv[2][2];
#pragma unroll
        for (int bj = 0; bj < 2; ++bj)
#pragma unroll
            for (int n = 0; n < 2; ++n) bv[bj][n] = (mode == 2) ? *(const f32x4*)(bgate + col0 + bj * HALF + 4 * n) : (f32x4){0.f, 0.f, 0.f, 0.f};
        const float sc = (mode == 1) ? qscale : 1.0f;
#pragma unroll
        for (int ai = 0; ai < 2; ++ai)
#pragma unroll
            for (int m = 0; m < 4; ++m) { bf16_t* rowp = base + (size_t)(srow0 + ai * HALF + m * 16) * ldc + scol0;
#pragma unroll
                for (int bj = 0; bj < 2; ++bj) { f32x4 v0 = acc[ai][bj][m][0] + bv[bj][0], v1 = acc[ai][bj][m][1] + bv[bj][1];
                    if (mode == 2) {
#pragma unroll
                        for (int e = 0; e < 4; ++e) { v0[e] = sigmoidf_fast(v0[e]); v1[e] = sigmoidf_fast(v1[e]); }
                    }
                    v0 = v0 * sc; v1 = v1 * sc; u32x4 w; w.x = cvt_pk_bf16(v0[0], v0[1]); w.y = cvt_pk_bf16(v0[2], v0[3]); w.z = cvt_pk_bf16(v1[0], v1[1]); w.w = cvt_pk_bf16(v1[2], v1[3]);
                    *(u32x4*)(rowp + bj * HALF) = xpose16(w, srca); } }
    }
};

template <bool FIRST> struct EpiGate {
    static constexpr bool PERM = true, AFTER_DRAIN = false, CARRY = false;
    const bf16_t* GT; const bf16_t* Tin; bf16_t* O;
    __device__ __forceinline__ void operator()(const f32x4 (&acc)[2][2][4][2], const Unit& u, int wr, int wc, int fr, int fq) const {
        const int row0 = u.pm * BM + wr * 64 + fr; const int col0 = u.pn * BM + wc * 32 + 8 * fq;
#pragma unroll
        for (int ai = 0; ai < 2; ++ai)
#pragma unroll
            for (int m = 0; m < 4; ++m) { const size_t row = (size_t)(row0 + ai * HALF + m * 16);
#pragma unroll
                for (int bj = 0; bj < 2; ++bj) {
                    const u32x4 g = *(const u32x4*)(GT + row * 2048 + (FIRST ? 0 : 1024) + col0 + bj * HALF);
                    f32x4 v0 = acc[ai][bj][m][0], v1 = acc[ai][bj][m][1];
                    v0[0] *= bf_lo(g.x); v0[1] *= bf_hi(g.x); v0[2] *= bf_lo(g.y); v0[3] *= bf_hi(g.y);
                    v1[0] *= bf_lo(g.z); v1[1] *= bf_hi(g.z); v1[2] *= bf_lo(g.w); v1[3] *= bf_hi(g.w);
                    if (!FIRST) { const u32x4 t = *(const u32x4*)(Tin + row * 1024 + col0 + bj * HALF);
                        v0[0] += bf_lo(t.x); v0[1] += bf_hi(t.x); v0[2] += bf_lo(t.y); v0[3] += bf_hi(t.y);
                        v1[0] += bf_lo(t.z); v1[1] += bf_hi(t.z); v1[2] += bf_lo(t.w); v1[3] += bf_hi(t.w); }
                    u32x4 w; w.x = cvt_pk_bf16(v0[0], v0[1]); w.y = cvt_pk_bf16(v0[2], v0[3]); w.z = cvt_pk_bf16(v1[0], v1[1]); w.w = cvt_pk_bf16(v1[2], v1[3]);
                    *(u32x4*)(O + row * 1024 + col0 + bj * HALF) = w; } }
    }
};

template <bool WITH_BF16, bool F32OUT, bool BF16BASE> struct EpiRes {
    static constexpr bool PERM = false, AFTER_DRAIN = false, CARRY = false;
    const float* base; const bf16_t* baseb; float* out; bf16_t* ob; float* rowss;
    __device__ __forceinline__ void operator()(const f32x4 (&acc)[2][2][4][2], const Unit& u, int wr, int wc, int fr, int fq) const {
        typedef unsigned u32x2v __attribute__((ext_vector_type(2)));
        const int row0 = u.pm * BM + wr * 64 + fr; const int col0 = u.pn * BM + wc * 32 + 4 * fq;
#pragma unroll
        for (int ai = 0; ai < 2; ++ai)
#pragma unroll
            for (int m = 0; m < 4; ++m) { const int row = row0 + ai * HALF + m * 16; const size_t off = (size_t)row * 1024 + col0; float ss = 0.f;
#pragma unroll
                for (int bj = 0; bj < 2; ++bj)
#pragma unroll
                    for (int n = 0; n < 2; ++n) { f32x4 bs;
                        if (BF16BASE) { const u32x2v t = *(const u32x2v*)(baseb + off + bj * HALF + n * 16); bs = (f32x4){bf_lo(t.x), bf_hi(t.x), bf_lo(t.y), bf_hi(t.y)}; }
                        else bs = *(const f32x4*)(base + off + bj * HALF + n * 16);
                        const f32x4 v = bs + acc[ai][bj][m][n];
                        if (F32OUT) *(f32x4*)(out + off + bj * HALF + n * 16) = v;
                        ss += (v[0] * v[0] + v[1] * v[1]) + (v[2] * v[2] + v[3] * v[3]);
                        if (WITH_BF16) { u32x2v w; w.x = cvt_pk_bf16(v[0], v[1]); w.y = cvt_pk_bf16(v[2], v[3]); *(u32x2v*)(ob + off + bj * HALF + n * 16) = w; } }
                ss += __shfl_xor(ss, 16); ss += __shfl_xor(ss, 32);
                if (fq == 0) atomicAdd(rowss + row, ss); }
    }
};

struct EpiMlp {
    static constexpr bool PERM = true, AFTER_DRAIN = false, CARRY = false;
    bf16_t* O; const float* rowss; float eps;
    __device__ __forceinline__ void operator()(const f32x4 (&acc)[2][2][4][2], const Unit& u, int wr, int wc, int fr, int fq) const {
        const int row0 = u.pm * BM + wr * 64 + fr; const int col0 = u.pn * BM + wc * 32 + 8 * fq;
        const int ln = threadIdx.x & 63, sfr = ln >> 2, sfq = ln & 3, srca = (sfr + 16 * sfq) * 4;
        const int srow0 = u.pm * BM + wr * 64 + sfr, scol0 = u.pn * BM + wc * 32 + 8 * sfq;
#pragma unroll
        for (int ai = 0; ai < 2; ++ai)
#pragma unroll
            for (int m = 0; m < 4; ++m) { const int row = row0 + ai * HALF + m * 16; const float rs = __builtin_amdgcn_rsqf(rowss[row] * (1.0f / 1024.0f) + eps);
                bf16_t* rowp = O + (size_t)(srow0 + ai * HALF + m * 16) * 4096 + scol0;
#pragma unroll
                for (int bj = 0; bj < 2; ++bj) { f32x4 v0 = acc[ai][bj][m][0] * rs, v1 = acc[ai][bj][m][1] * rs;
#pragma unroll
                    for (int e = 0; e < 4; ++e) { const float a = fmaxf(v0[e], 0.f), b = fmaxf(v1[e], 0.f); v0[e] = a * a; v1[e] = b * b; }
                    u32x4 w; w.x = cvt_pk_bf16(v0[0], v0[1]); w.y = cvt_pk_bf16(v0[2], v0[3]); w.z = cvt_pk_bf16(v1[0], v1[1]); w.w = cvt_pk_bf16(v1[2], v1[3]);
                    *(u32x4*)(rowp + bj * HALF) = xpose16(w, srca); } }
    }
};

struct EpiFinal {
    static constexpr bool PERM = false, AFTER_DRAIN = false, CARRY = false;
    const bf16_t* base; float* out; float* rowss; unsigned* cnt; const float* gfin; float eps;
    __device__ __forceinline__ void operator()(f32x4 (&acc)[2][2][4][2], const Unit& u, int wr, int wc, int fr, int fq) const {
        const int row0 = u.pm * BM + wr * 64 + fr; const int col0 = u.pn * BM + wc * 32 + 4 * fq;
#pragma unroll
        for (int ai = 0; ai < 2; ++ai)
#pragma unroll
            for (int m = 0; m < 4; ++m) { const int row = row0 + ai * HALF + m * 16; const size_t off = (size_t)row * 1024 + col0; float ss = 0.f;
#pragma unroll
                for (int bj = 0; bj < 2; ++bj)
#pragma unroll
                    for (int n = 0; n < 2; ++n) { typedef unsigned u32x2v __attribute__((ext_vector_type(2))); const u32x2v t = *(const u32x2v*)(base + off + bj * HALF + n * 16);
                        const f32x4 v = (f32x4){bf_lo(t.x), bf_hi(t.x), bf_lo(t.y), bf_hi(t.y)} + acc[ai][bj][m][n];
                        acc[ai][bj][m][n] = v; ss += (v[0] * v[0] + v[1] * v[1]) + (v[2] * v[2] + v[3] * v[3]); }
                ss += __shfl_xor(ss, 16); ss += __shfl_xor(ss, 32);
                if (fq == 0) __hip_atomic_store(rowss + (size_t)row * 16 + u.pn * 4 + wc, ss, __ATOMIC_RELAXED, __HIP_MEMORY_SCOPE_AGENT); }
        asm volatile("s_waitcnt vmcnt(0)" ::: "memory");
        unsigned* c = cnt + 64 * u.pm;
        if ((threadIdx.x & 63) == 0) __hip_atomic_fetch_add(c, 1u, __ATOMIC_RELAXED, __HIP_MEMORY_SCOPE_AGENT);
        { unsigned sp = 0;
          while ((unsigned)__builtin_amdgcn_readfirstlane(__hip_atomic_load(c, __ATOMIC_RELAXED, __HIP_MEMORY_SCOPE_AGENT)) < 32u) { __builtin_amdgcn_s_sleep(2); if (++sp > (1u << 22)) break; } }
        asm volatile("" ::: "memory");
#pragma unroll
        for (int ai = 0; ai < 2; ++ai)
#pragma unroll
            for (int m = 0; m < 4; ++m) { const int row = row0 + ai * HALF + m * 16; const size_t off = (size_t)row * 1024 + col0;
                float tot = 0.f;
#pragma unroll
                for (int e = 0; e < 4; ++e) tot += __hip_atomic_load(rowss + (size_t)row * 16 + 4 * fq + e, __ATOMIC_RELAXED, __HIP_MEMORY_SCOPE_AGENT);
                tot += __shfl_xor(tot, 16); tot += __shfl_xor(tot, 32);
                const float rs = __builtin_amdgcn_rsqf(tot * (1.0f / 1024.0f) + eps);
#pragma unroll
                for (int bj = 0; bj < 2; ++bj)
#pragma unroll
                    for (int n = 0; n < 2; ++n) { const f32x4 g = *(const f32x4*)(gfin + col0 + bj * HALF + n * 16);
                        *(f32x4*)(out + off + bj * HALF + n * 16) = acc[ai][bj][m][n] * rs * g; } }
    }
};

struct EpiGatePair {
    static constexpr bool PERM = true, AFTER_DRAIN = false, CARRY = true;
    const bf16_t* GT; bf16_t* O;
    __device__ __forceinline__ void operator()(f32x4 (&acc)[2][2][4][2], const Unit& u, int wr, int wc, int fr, int fq) const {
        const bool second = (u.pm >= 64);
        const int row0 = (u.pm & 63) * BM + wr * 64 + fr; const int col0 = (u.pn & 3) * BM + wc * 32 + 8 * fq;
#pragma unroll
        for (int ai = 0; ai < 2; ++ai)
#pragma unroll
            for (int m = 0; m < 4; ++m) { const size_t row = (size_t)(row0 + ai * HALF + m * 16);
#pragma unroll
                for (int bj = 0; bj < 2; ++bj) {
                    const u32x4 gb = *(const u32x4*)(GT + row * 2048 + 1024 + col0 + bj * HALF);
                    f32x4 v0 = acc[ai][bj][m][0], v1 = acc[ai][bj][m][1];
                    if (!second) {
                        const u32x4 ga = *(const u32x4*)(GT + row * 2048 + col0 + bj * HALF);
                        v0[0] *= bf_lo(ga.x) * __builtin_amdgcn_rcpf(bf_lo(gb.x)); v0[1] *= bf_hi(ga.x) * __builtin_amdgcn_rcpf(bf_hi(gb.x)); v0[2] *= bf_lo(ga.y) * __builtin_amdgcn_rcpf(bf_lo(gb.y)); v0[3] *= bf_hi(ga.y) * __builtin_amdgcn_rcpf(bf_hi(gb.y));
                        v1[0] *= bf_lo(ga.z) * __builtin_amdgcn_rcpf(bf_lo(gb.z)); v1[1] *= bf_hi(ga.z) * __builtin_amdgcn_rcpf(bf_hi(gb.z)); v1[2] *= bf_lo(ga.w) * __builtin_amdgcn_rcpf(bf_lo(gb.w)); v1[3] *= bf_hi(ga.w) * __builtin_amdgcn_rcpf(bf_hi(gb.w));
                        acc[ai][bj][m][0] = v0; acc[ai][bj][m][1] = v1;
                    } else {
                        v0[0] *= bf_lo(gb.x); v0[1] *= bf_hi(gb.x); v0[2] *= bf_lo(gb.y); v0[3] *= bf_hi(gb.y);
                        v1[0] *= bf_lo(gb.z); v1[1] *= bf_hi(gb.z); v1[2] *= bf_lo(gb.w); v1[3] *= bf_hi(gb.w);
                        u32x4 w; w.x = cvt_pk_bf16(v0[0], v0[1]); w.y = cvt_pk_bf16(v0[2], v0[3]); w.z = cvt_pk_bf16(v1[0], v1[1]); w.w = cvt_pk_bf16(v1[2], v1[3]);
                        *(u32x4*)(O + row * 1024 + col0 + bj * HALF) = w;
                        acc[ai][bj][m][0] = (f32x4){0.f, 0.f, 0.f, 0.f}; acc[ai][bj][m][1] = (f32x4){0.f, 0.f, 0.f, 0.f};
                    } } }
    }
};
struct PairOrder {
    StaticOrder so;
    __host__ __device__ void init(int M, int N, int G_, int c_) { so.init(M, N, G_, c_); }
    __host__ __device__ bool next(int i, Unit& u) const { if (!so.next(i >> 1, u)) return false; if (i & 1) { u.pm += 64; u.pn += 4; } return true; }
    __device__ __forceinline__ void a_ready(const Unit&) const {}
    __device__ __forceinline__ void done(const Unit&) const {}
};

template <class Epi, class Sched, bool ALIGN_EPI = false, bool SP2 = false>
__device__ __forceinline__ void gemm_phase(PG8_LAS unsigned char* lds, const Gemm g, const Sched& S, const Epi& E) {
    const int tid = threadIdx.x, wid = __builtin_amdgcn_readfirstlane(tid >> 6), lane = tid & 63, wr = wid >> 2, wc = wid & 3, fr = lane & 15, fq = lane >> 4;
    const int K = g.K, nt = K / BK;
    unsigned voffA[2], voffB[2];
#pragma unroll
    for (int i = 0; i < 2; ++i) { int R, C; stage_rc(tid * 16 + i * 8192, R, C); const int Rb = Epi::PERM ? ((R & ~31) + perm32(R & 31)) : R;
        voffA[i] = (unsigned)(R * K + C) * 2u; voffB[i] = (unsigned)(Rb * K + C) * 2u; }
    const size_t kstep = (size_t)(BK * 2);
    const size_t hstep = (size_t)HALF * K * 2;
    const size_t tstep = 2 * hstep;
    const unsigned ldsw = (unsigned)wid * 1024u;
    const int aoff = lds_byte(wr * 64 + fr, fq * 8), boff = lds_byte(wc * 32 + fr, fq * 8);
#define PG8_SA(b, h) (((b) * 2 + (h)) * HTB)
#define PG8_SB(b, h) ((4 + (b) * 2 + (h)) * HTB)
#define PG8_STAGE(bufoff, gbase, voff) do { _Pragma("unroll") for (int _i = 0; _i < 2; ++_i) \
        __builtin_amdgcn_global_load_lds((const unsigned*)((const char*)(gbase) + (voff)[_i]), (PG8_LAS unsigned*)(lds + (bufoff) + ldsw + _i * 8192), 16, 0, 0); } while (0)
#define PG8_LDA(dst, b, h) do { _Pragma("unroll") for (int m = 0; m < 4; ++m) _Pragma("unroll") for (int k = 0; k < 2; ++k) dst[m][k] = *(const PG8_LAS bf16x8*)(lds + PG8_SA(b, h) + aoff + m * 2048 + k * 1024); } while (0)
#define PG8_LDB(dst, b, h) do { _Pragma("unroll") for (int n = 0; n < 2; ++n) _Pragma("unroll") for (int k = 0; k < 2; ++k) dst[n][k] = *(const PG8_LAS bf16x8*)(lds + PG8_SB(b, h) + boff + n * 2048 + k * 1024); } while (0)
#define PG8_MMA(ai, bj, At, Bt) do { __builtin_amdgcn_s_setprio(1); _Pragma("unroll") for (int m = 0; m < 4; ++m) _Pragma("unroll") for (int n = 0; n < 2; ++n) _Pragma("unroll") for (int k = 0; k < 2; ++k) \
        acc[ai][bj][m][n] = __builtin_amdgcn_mfma_f32_16x16x32_bf16(Bt[n][k], At[m][k], acc[ai][bj][m][n], 0, 0, 0); __builtin_amdgcn_s_setprio(0); } while (0)
#define PG8_WAIT_V(n) asm volatile("s_waitcnt vmcnt(" #n ")" ::: "memory")
#define PG8_WAIT_L(n) asm volatile("s_waitcnt lgkmcnt(" #n ")" ::: "memory")
#define PG8_BAR __builtin_amdgcn_s_barrier()
#define PG8_SCHED __builtin_amdgcn_sched_barrier(0)
    Unit cur, nxt; int ui = 0;
    if (!S.next(0, cur)) return;
    f32x4 acc[2][2][4][2];
#pragma unroll
    for (int a = 0; a < 2; ++a)
#pragma unroll
        for (int b = 0; b < 2; ++b)
#pragma unroll
            for (int m = 0; m < 4; ++m)
#pragma unroll
                for (int n = 0; n < 2; ++n) acc[a][b][m][n] = (f32x4){0.f, 0.f, 0.f, 0.f};
    bf16x8 At[4][2], B0[2][2], B1[2][2];
    const char* cA = (const char*)g.A + (size_t)cur.pm * tstep; const char* cB = (const char*)g.Bt + (size_t)cur.pn * tstep;
    S.a_ready(cur);
    if constexpr (SP2) {
        PG8_STAGE(PG8_SB(0, 0), cB, voffB); PG8_STAGE(PG8_SB(0, 1), cB + hstep, voffB); PG8_STAGE(PG8_SA(0, 0), cA, voffA); PG8_STAGE(PG8_SA(0, 1), cA + hstep, voffA);
        if (wr == 1) PG8_BAR;
        PG8_WAIT_V(2); PG8_BAR;
        PG8_STAGE(PG8_SB(1, 0), cB + kstep, voffB); PG8_STAGE(PG8_SA(1, 0), cA + kstep, voffA); PG8_STAGE(PG8_SB(1, 1), cB + hstep + kstep, voffB);
        PG8_WAIT_V(6); PG8_BAR;
    } else {
        PG8_STAGE(PG8_SB(0, 0), cB, voffB); PG8_STAGE(PG8_SA(0, 0), cA, voffA); PG8_STAGE(PG8_SB(0, 1), cB + hstep, voffB); PG8_STAGE(PG8_SA(0, 1), cA + hstep, voffA);
        if (wr == 1) PG8_BAR;
        PG8_WAIT_V(4); PG8_BAR;
        PG8_STAGE(PG8_SB(1, 0), cB + kstep, voffB); PG8_STAGE(PG8_SA(1, 0), cA + kstep, voffA); PG8_STAGE(PG8_SB(1, 1), cB + hstep + kstep, voffB);
        PG8_WAIT_V(6); PG8_BAR;
    }
    for (;;) {
        const bool has_next = S.next(ui + 1, nxt);
        const char* nA = has_next ? (const char*)g.A + (size_t)nxt.pm * tstep : cA; const char* nB = has_next ? (const char*)g.Bt + (size_t)nxt.pn * tstep : cB;
        for (int t = 0; t < nt; t += 2) {
            const bool last = (t == nt - 2);
            const char* a1 = cA + (size_t)(t + 1) * kstep;
            const char* a2 = last ? nA : cA + (size_t)(t + 2) * kstep; const char* b2 = last ? nB : cB + (size_t)(t + 2) * kstep;
            const char* a3 = a2 + kstep; const char* b3 = b2 + kstep;
            if (last && has_next) S.a_ready(nxt);
            if constexpr (SP2) {
            PG8_LDB(B0, 0, 0); PG8_LDB(B1, 0, 1); PG8_SCHED; PG8_LDA(At, 0, 0); PG8_STAGE(PG8_SA(1, 1), a1 + hstep, voffA);
            PG8_WAIT_V(8); PG8_WAIT_L(0); PG8_BAR; PG8_MMA(0, 0, At, B0); PG8_MMA(0, 1, At, B1); PG8_BAR; PG8_SCHED;
            PG8_LDA(At, 0, 1); PG8_STAGE(PG8_SB(0, 0), b2, voffB); PG8_STAGE(PG8_SB(0, 1), b2 + hstep, voffB); PG8_STAGE(PG8_SA(0, 0), a2, voffA);
            PG8_WAIT_V(8); PG8_WAIT_L(0); PG8_BAR; PG8_MMA(1, 0, At, B0); PG8_MMA(1, 1, At, B1); PG8_BAR; PG8_SCHED;
            PG8_LDB(B0, 1, 0); PG8_LDB(B1, 1, 1); PG8_SCHED; PG8_LDA(At, 1, 0); PG8_STAGE(PG8_SA(0, 1), a2 + hstep, voffA);
            PG8_WAIT_V(8); PG8_WAIT_L(0); PG8_BAR; PG8_MMA(0, 0, At, B0); PG8_MMA(0, 1, At, B1); PG8_BAR; PG8_SCHED;
            PG8_LDA(At, 1, 1); PG8_STAGE(PG8_SB(1, 0), b3, voffB); PG8_STAGE(PG8_SB(1, 1), b3 + hstep, voffB); PG8_STAGE(PG8_SA(1, 0), a3, voffA);
            PG8_WAIT_V(8); PG8_WAIT_L(0); PG8_BAR; PG8_MMA(1, 0, At, B0); PG8_MMA(1, 1, At, B1); PG8_BAR; PG8_SCHED;
            } else {
            PG8_LDB(B0, 0, 0); PG8_SCHED; PG8_LDA(At, 0, 0); PG8_STAGE(PG8_SA(1, 1), a1 + hstep, voffA);
            PG8_WAIT_L(8); PG8_BAR; PG8_WAIT_L(0); PG8_MMA(0, 0, At, B0); PG8_BAR; PG8_SCHED;
            PG8_LDB(B1, 0, 1); PG8_STAGE(PG8_SB(0, 0), b2, voffB);
            PG8_BAR; PG8_WAIT_L(0); PG8_MMA(0, 1, At, B1); PG8_BAR;
            PG8_LDA(At, 0, 1); PG8_STAGE(PG8_SA(0, 0), a2, voffA);
            PG8_BAR; PG8_WAIT_L(0); PG8_MMA(1, 0, At, B0); PG8_BAR; PG8_SCHED;
            PG8_STAGE(PG8_SB(0, 1), b2 + hstep, voffB);
            PG8_WAIT_V(6); PG8_BAR; PG8_MMA(1, 1, At, B1); PG8_BAR;
            PG8_LDB(B0, 1, 0); PG8_SCHED; PG8_LDA(At, 1, 0); PG8_STAGE(PG8_SA(0, 1), a2 + hstep, voffA);
            PG8_WAIT_L(8); PG8_BAR; PG8_WAIT_L(0); PG8_MMA(0, 0, At, B0); PG8_BAR; PG8_SCHED;
            PG8_LDB(B1, 1, 1); PG8_STAGE(PG8_SB(1, 0), b3, voffB);
            PG8_BAR; PG8_WAIT_L(0); PG8_MMA(0, 1, At, B1); PG8_BAR;
            PG8_LDA(At, 1, 1); PG8_STAGE(PG8_SA(1, 0), a3, voffA);
            PG8_BAR; PG8_WAIT_L(0); PG8_MMA(1, 0, At, B0); PG8_BAR; PG8_SCHED;
            PG8_STAGE(PG8_SB(1, 1), b3 + hstep, voffB);
            PG8_WAIT_V(6); PG8_BAR; PG8_MMA(1, 1, At, B1); PG8_BAR;
            }
        }
        if constexpr (ALIGN_EPI) { if (wr == 0) PG8_BAR; }
        if constexpr (!Epi::AFTER_DRAIN) { E(acc, cur, wr, wc, fr, fq); S.done(cur); }
        if (!has_next) break;
        if constexpr (!Epi::CARRY)
#pragma unroll
        for (int a = 0; a < 2; ++a)
#pragma unroll
            for (int b = 0; b < 2; ++b)
#pragma unroll
                for (int m = 0; m < 4; ++m)
#pragma unroll
                    for (int n = 0; n < 2; ++n) acc[a][b][m][n] = (f32x4){0.f, 0.f, 0.f, 0.f};
        cur = nxt; cA = nA; cB = nB; ++ui;
        if constexpr (ALIGN_EPI) { if (wr == 1) PG8_BAR; }
    }
    PG8_WAIT_V(0);
    if constexpr (!ALIGN_EPI) { if (wr == 0) PG8_BAR; }
    PG8_BAR;
    if constexpr (Epi::AFTER_DRAIN) { E.fused(acc, cur, wr, wc, fr, fq, lds, wid, lane); S.done(cur); }
#undef PG8_SA
#undef PG8_SB
#undef PG8_STAGE
#undef PG8_LDA
#undef PG8_LDB
#undef PG8_MMA
#undef PG8_WAIT_V
#undef PG8_WAIT_L
#undef PG8_BAR
#undef PG8_SCHED
}
}

constexpr int NWAVES = 8;
constexpr int BATCH = 4, SEQ = 4096, D = 1024, M = BATCH * SEQ, NIN = 5120, FF = 4096, CW = 512, DW = 512, NH = 4;
constexpr float RMS_EPS = 1e-6f;
constexpr float LOG2E = 1.4426950408889634f;
#ifndef MK_N_LAUNCHES
#define MK_N_LAUNCHES 1
#endif
constexpr int N_PHASES = 8;
#ifndef PROBE_P2_PART
#define PROBE_P2_PART 3
#endif
#ifndef PROBE_DUP_MASK
#define PROBE_DUP_MASK 0
#endif
#define REPS(k) (1 + ((PROBE_DUP_MASK >> (k)) & 1))

constexpr size_t MiB = 1u << 20;
constexpr size_t WS_RSS1 = 0, WS_RSS2 = 65536;
constexpr size_t WS_BAR = 131072, WS_CNT = WS_BAR + 16384, WS_BAR_BYTES = 49152;
constexpr size_t WS_WIN = 1 * MiB;
constexpr size_t WS_WA = 11 * MiB, WS_WB = 12 * MiB;
constexpr size_t WS_WO = 13 * MiB;
constexpr size_t WS_WMI = 15 * MiB;
constexpr size_t WS_WMO = 23 * MiB;
constexpr size_t WS_SLOT = 31 * MiB;
constexpr size_t WS_XN = 32 * MiB;
constexpr size_t WS_UA = 64 * MiB;
constexpr size_t WS_UQ = 112 * MiB;
constexpr size_t WS_GT = 160 * MiB;
constexpr size_t WS_CA = 224 * MiB;
constexpr size_t WS_ON = 240 * MiB;
constexpr size_t WS_MB = 64 * MiB;
constexpr size_t WS_TB = 96 * MiB;
constexpr size_t WS_HB = 64 * MiB;
constexpr size_t WS_END = 256 * MiB;

constexpr int RING_BYTES = 131072;
constexpr int ATT_LDS = 4 * 38912;
constexpr int LDS_BYTES = ATT_LDS + 1024;

#define GAS __attribute__((address_space(1)))
#define LAS __attribute__((address_space(3)))
typedef unsigned short bf16;
typedef unsigned v4u __attribute__((ext_vector_type(4)));
typedef unsigned v2u __attribute__((ext_vector_type(2)));
typedef float f32x4 __attribute__((ext_vector_type(4)));
typedef float f32x16 __attribute__((ext_vector_type(16)));
typedef short bf16x8 __attribute__((ext_vector_type(8)));
typedef short s16x4 __attribute__((ext_vector_type(4)));
#define LDS_WAIT() asm volatile("s_waitcnt lgkmcnt(0)" ::: "memory")
__device__ __forceinline__ unsigned f2bf(float f) { unsigned u = __builtin_bit_cast(unsigned, f); return (u + 0x7fffu + ((u >> 16) & 1u)) >> 16; }
__device__ __forceinline__ unsigned pk2(float lo, float hi) { return f2bf(lo) | (f2bf(hi) << 16); }
__device__ __forceinline__ float bflo(unsigned w) { return __uint_as_float(w << 16); }
__device__ __forceinline__ float bfhi(unsigned w) { return __uint_as_float(w & 0xffff0000u); }
__device__ __forceinline__ float wave_sum(float v) {
#pragma unroll
    for (int o = 1; o < 64; o <<= 1) v += __shfl_xor(v, o);
    return v;
}

__device__ __forceinline__ void p0_transpose_item(const float* W, const float* gain, int K, int N, bf16* WT, LAS float* scr, int item, int lane) {
    const int nblk = N / 32, kb = item / nblk, nb = item % nblk, k0 = 64 * kb, n0 = 32 * nb;
    float wv_[32];
#pragma unroll
    for (int i = 0; i < 32; ++i) { const int kk = 2 * i + (lane >> 5); wv_[i] = W[(size_t)(k0 + kk) * N + n0 + (lane & 31)]; }
    if (gain) {
#pragma unroll
        for (int i = 0; i < 32; ++i) wv_[i] *= gain[k0 + 2 * i + (lane >> 5)];
    }
#pragma unroll
    for (int i = 0; i < 32; ++i) { const int kk = 2 * i + (lane >> 5); scr[kk * 33 + (lane & 31)] = wv_[i]; }
    LDS_WAIT(); asm volatile("" ::: "memory");
    const int c = lane & 7;
#pragma unroll
    for (int j = 0; j < 4; ++j) { const int n = (lane >> 3) + 8 * j; const LAS float* s = scr + (8 * c) * 33 + n;
        v4u o; o.x = pk2(s[0 * 33], s[1 * 33]); o.y = pk2(s[2 * 33], s[3 * 33]); o.z = pk2(s[4 * 33], s[5 * 33]); o.w = pk2(s[6 * 33], s[7 * 33]);
        *(GAS v4u*)(WT + (size_t)(n0 + n) * K + k0 + 8 * c) = o; }
    LDS_WAIT(); asm volatile("" ::: "memory");
}
__device__ __forceinline__ void rms_row_to_bf16(const float* xrow, const float* g, bf16* orow, int lane) {
    const GAS f32x4* xr = (const GAS f32x4*)xrow + lane; const GAS f32x4* gr = (const GAS f32x4*)g + lane;
    f32x4 v[4]; float s2 = 0.f;
#pragma unroll
    for (int j = 0; j < 4; ++j) { v[j] = xr[64 * j]; s2 += (v[j].x * v[j].x + v[j].y * v[j].y) + (v[j].z * v[j].z + v[j].w * v[j].w); }
    const float rstd = 1.f / sqrtf(wave_sum(s2) * (1.f / D) + RMS_EPS);
    GAS unsigned long long* o8 = (GAS unsigned long long*)orow + lane;
#pragma unroll
    for (int j = 0; j < 4; ++j) { const f32x4 gg = gr[64 * j];
        o8[64 * j] = (unsigned long long)pk2(v[j].x * rstd * gg.x, v[j].y * rstd * gg.y) | ((unsigned long long)pk2(v[j].z * rstd * gg.z, v[j].w * rstd * gg.w) << 32); }
}

__device__ __forceinline__ void rms_2rows_to_bf16(const float* xa, const float* xb, const float* g, bf16* oa, bf16* ob, int lane) {
    const GAS f32x4* xra = (const GAS f32x4*)xa + lane; const GAS f32x4* xrb = (const GAS f32x4*)xb + lane; const GAS f32x4* gr = (const GAS f32x4*)g + lane;
    f32x4 va[4], vb[4]; float sa = 0.f, sb = 0.f;
#pragma unroll
    for (int j = 0; j < 4; ++j) { va[j] = xra[64 * j]; vb[j] = xrb[64 * j]; }
#pragma unroll
    for (int j = 0; j < 4; ++j) { sa += (va[j].x * va[j].x + va[j].y * va[j].y) + (va[j].z * va[j].z + va[j].w * va[j].w); sb += (vb[j].x * vb[j].x + vb[j].y * vb[j].y) + (vb[j].z * vb[j].z + vb[j].w * vb[j].w); }
    const float ra = 1.f / sqrtf(wave_sum(sa) * (1.f / D) + RMS_EPS), rb = 1.f / sqrtf(wave_sum(sb) * (1.f / D) + RMS_EPS);
    GAS unsigned long long* o8a = (GAS unsigned long long*)oa + lane; GAS unsigned long long* o8b = (GAS unsigned long long*)ob + lane;
#pragma unroll
    for (int j = 0; j < 4; ++j) { const f32x4 gg = gr[64 * j];
        o8a[64 * j] = (unsigned long long)pk2(va[j].x * ra * gg.x, va[j].y * ra * gg.y) | ((unsigned long long)pk2(va[j].z * ra * gg.z, va[j].w * ra * gg.w) << 32);
        o8b[64 * j] = (unsigned long long)pk2(vb[j].x * rb * gg.x, vb[j].y * rb * gg.y) | ((unsigned long long)pk2(vb[j].z * rb * gg.z, vb[j].w * rb * gg.w) << 32); }
}

namespace att {
constexpr int PITCH = 1536;
constexpr int KROW = 144, VROW = 320;
constexpr int K0_OFF = 0, K1_OFF = 64 * KROW, V_OFF = 2 * 64 * KROW, STAGE = V_OFF + 64 * VROW;
static_assert(4 * STAGE == ATT_LDS && 65536 <= 2 * STAGE, "attention LDS map");
__device__ __forceinline__ int crow(int r, int hi) { return (r & 3) + 8 * (r >> 2) + 4 * hi; }
__device__ __forceinline__ unsigned cvtpk(float lo, float hi) { unsigned r; asm volatile("v_cvt_pk_bf16_f32 %0, %1, %2" : "=v"(r) : "v"(lo), "v"(hi)); return r; }
__device__ __forceinline__ float max3f(float a, float b, float c) { float r; asm("v_max3_f32 %0, %1, %2, %3" : "=v"(r) : "v"(a), "v"(b), "v"(c)); return r; }
__device__ __forceinline__ s16x4 vtr(LAS const unsigned char* p) { return __builtin_bit_cast(s16x4, __builtin_amdgcn_ds_read_tr16_b64_v4i16((LAS s16x4*)p)); }

__device__ __forceinline__ void unit(int b, int h, int qb, const bf16* UQ, bf16* ON, const float* subg, float lam, LAS unsigned char* lds) {
    const int tid = threadIdx.x, lane = tid & 63, r32 = lane & 31, hi = lane >> 5;
    const int wid = __builtin_amdgcn_readfirstlane(tid >> 6), c = wid >> 2, w = wid & 3;
    const size_t seq0 = (size_t)b * SEQ;
    const int qw0 = 128 * qb + 32 * w, qpos = qw0 + r32;
    const float slope2 = exp2f(-2.0f * (float)(h + 1)) * LOG2E;
    int tidl = tid; asm volatile("" : "+v"(tidl));
    const int krow = tidl >> 3, kch = tidl & 7, vrow = tidl >> 4, vch = tidl & 15;
    const bf16* gk = UQ + (seq0 + krow) * PITCH + 512 + h * 128 + kch * 8;
    const bf16* gv = UQ + (seq0 + vrow) * PITCH + 1024 + h * 128 + vch * 8;
    const unsigned wk = krow * KROW + kch * 16, wv = V_OFF + vrow * VROW + vch * 16;
    LAS const unsigned char* kbase = lds + (c ? K1_OFF : K0_OFF) + r32 * KROW + hi * 16;
    const int gi = lane & 15;
    LAS const unsigned char* vbase = lds + V_OFF + (4 * hi + (gi >> 2)) * VROW + (16 * ((lane >> 4) & 1) + 4 * (gi & 3)) * 2;
    bf16x8 qf[4];
    { const bf16* qp = UQ + (seq0 + qpos) * PITCH + h * 128 + c * 64 + hi * 8;
#pragma unroll
      for (int s = 0; s < 4; ++s) qf[s] = *(const bf16x8*)(qp + 16 * s); }
    asm volatile("" : "+v"(qf[0]), "+v"(qf[1]), "+v"(qf[2]), "+v"(qf[3]));
    f32x16 o[4];
#pragma unroll
    for (int db = 0; db < 4; ++db)
#pragma unroll
        for (int r = 0; r < 16; ++r) o[db][r] = 0.f;
    float mref = 0.f, lrun = 0.f;
    constexpr float THR = 60.0f;
    const int NT = 2 * (qb + 1);
    v4u sk0, sk1, sv0, sv1;
    sk0 = *(const v4u*)gk; sk1 = *(const v4u*)(gk + 64); sv0 = *(const v4u*)gv; sv1 = *(const v4u*)(gv + 32 * PITCH);
    *(LAS v4u*)(lds + K0_OFF + wk) = sk0; *(LAS v4u*)(lds + K1_OFF + wk) = sk1; *(LAS v4u*)(lds + wv) = sv0; *(LAS v4u*)(lds + wv + 32 * VROW) = sv1;
    asm volatile("" : "+v"(qf[0]), "+v"(qf[1]), "+v"(qf[2]), "+v"(qf[3]));
    { const size_t go = (size_t)64 * PITCH; sk0 = *(const v4u*)(gk + go); sk1 = *(const v4u*)(gk + go + 64); sv0 = *(const v4u*)(gv + go); sv1 = *(const v4u*)(gv + go + 32 * PITCH); }
    *(LAS v4u*)(lds + STAGE + K0_OFF + wk) = sk0; *(LAS v4u*)(lds + STAGE + K1_OFF + wk) = sk1; *(LAS v4u*)(lds + STAGE + wv) = sv0; *(LAS v4u*)(lds + STAGE + wv + 32 * VROW) = sv1;
    if (NT > 2) { const size_t go = (size_t)128 * PITCH; sk0 = *(const v4u*)(gk + go); sk1 = *(const v4u*)(gk + go + 64); sv0 = *(const v4u*)(gv + go); sv1 = *(const v4u*)(gv + go + 32 * PITCH); }
    asm volatile("s_waitcnt lgkmcnt(0)\n\ts_barrier" ::: "memory");
#define VREAD(dst, kk) do { _Pragma("unroll") for (int db_ = 0; db_ < 4; ++db_) { LAS const unsigned char* vp_ = vbase + boff + (16 * (kk)) * VROW + db_ * 64; \
        const s16x4 lo_ = vtr(vp_), hh_ = vtr(vp_ + 8 * VROW); dst[db_] = (bf16x8){lo_[0], lo_[1], lo_[2], lo_[3], hh_[0], hh_[1], hh_[2], hh_[3]}; } } while (0)
#define MMA4(vv, pp) do { _Pragma("unroll") for (int db_ = 0; db_ < 4; ++db_) o[db_] = __builtin_amdgcn_mfma_f32_32x32x16_bf16(vv[db_], pp, o[db_], 0, 0, 0); } while (0)
#define SB() __builtin_amdgcn_sched_barrier(0)
    for (int t = 0; t < NT; ++t) {
        const int boff = (t & 3) * STAGE;
        if (t + 2 < NT) { const int nb = ((t + 2) & 3) * STAGE;
            *(LAS v4u*)(lds + nb + K0_OFF + wk) = sk0; *(LAS v4u*)(lds + nb + K1_OFF + wk) = sk1; *(LAS v4u*)(lds + nb + wv) = sv0; *(LAS v4u*)(lds + nb + wv + 32 * VROW) = sv1; }
        if (t + 3 < NT) { const size_t go = (size_t)(t + 3) * 64 * PITCH;
            sk0 = *(const v4u*)(gk + go); sk1 = *(const v4u*)(gk + go + 64); sv0 = *(const v4u*)(gv + go); sv1 = *(const v4u*)(gv + go + 32 * PITCH); }
        const int kt0 = 64 * t;
        if (kt0 <= qw0 + 31) {
            f32x16 p0, p1;
            { const float base0 = fmaf(slope2, (float)(kt0 - qpos + 4 * hi), -mref), base1 = base0 + 32.0f * slope2;
#pragma unroll
              for (int r = 0; r < 16; ++r) { const float cr = (float)((r & 3) + 8 * (r >> 2)); p0[r] = fmaf(slope2, cr, base0); p1[r] = fmaf(slope2, cr, base1); } }
#pragma unroll
            for (int s = 0; s < 4; ++s) {
                const bf16x8 k0f = *(LAS const bf16x8*)(kbase + boff + s * 32);
                const bf16x8 k1f = *(LAS const bf16x8*)(kbase + boff + 32 * KROW + s * 32);
                p0 = __builtin_amdgcn_mfma_f32_32x32x16_bf16(k0f, qf[s], p0, 0, 0, 0);
                p1 = __builtin_amdgcn_mfma_f32_32x32x16_bf16(k1f, qf[s], p1, 0, 0, 0);
            }
            bf16x8 vA[4], vB[4];
            VREAD(vA, 0); SB();
            if (kt0 + 63 > qw0) {
#pragma unroll
                for (int r = 0; r < 16; ++r) { const int kv = kt0 + crow(r, hi); if (kv > qpos) p0[r] = -INFINITY; if (kv + 32 > qpos) p1[r] = -INFINITY; }
            }
            asm volatile("s_nop 15\n\ts_nop 3" : "+v"(p0), "+v"(p1));
            float mx = max3f(p0[0], p1[0], p0[1]), mx2 = max3f(p1[1], p0[2], p1[2]);
#pragma unroll
            for (int r = 3; r < 15; r += 2) { mx = max3f(mx, p0[r], p1[r]); mx2 = max3f(mx2, p0[r + 1], p1[r + 1]); }
            mx = max3f(mx, p0[15], p1[15]);
            mx = max3f(mx, mx2, __shfl_xor(fmaxf(mx, mx2), 32));
            if (t == 0 || __any(mx > THR)) {
                const float dl = (t == 0) ? mx : fmaxf(mx, 0.f);
                mref += dl;
                const float f = (t == 0) ? 1.0f : __builtin_amdgcn_exp2f(-dl);
                lrun *= f;
#pragma unroll
                for (int r = 0; r < 16; ++r) { p0[r] -= dl; p1[r] -= dl; }
#pragma unroll
                for (int db = 0; db < 4; ++db)
#pragma unroll
                    for (int r = 0; r < 16; ++r) o[db][r] *= f;
            }
            float ls = 0.f;
#pragma unroll
            for (int r = 0; r < 16; ++r) { p0[r] = __builtin_amdgcn_exp2f(p0[r]); p1[r] = __builtin_amdgcn_exp2f(p1[r]); ls += p0[r] + p1[r]; }
            lrun += ls;
            bf16x8 pa[4];
            { v4u x;
              x.x = cvtpk(p0[0], p0[1]); x.y = cvtpk(p0[2], p0[3]); x.z = cvtpk(p0[4], p0[5]); x.w = cvtpk(p0[6], p0[7]); pa[0] = __builtin_bit_cast(bf16x8, x);
              x.x = cvtpk(p0[8], p0[9]); x.y = cvtpk(p0[10], p0[11]); x.z = cvtpk(p0[12], p0[13]); x.w = cvtpk(p0[14], p0[15]); pa[1] = __builtin_bit_cast(bf16x8, x);
              x.x = cvtpk(p1[0], p1[1]); x.y = cvtpk(p1[2], p1[3]); x.z = cvtpk(p1[4], p1[5]); x.w = cvtpk(p1[6], p1[7]); pa[2] = __builtin_bit_cast(bf16x8, x);
              x.x = cvtpk(p1[8], p1[9]); x.y = cvtpk(p1[10], p1[11]); x.z = cvtpk(p1[12], p1[13]); x.w = cvtpk(p1[14], p1[15]); pa[3] = __builtin_bit_cast(bf16x8, x); }
            SB(); VREAD(vB, 1); MMA4(vA, pa[0]); VREAD(vA, 2); MMA4(vB, pa[1]); VREAD(vB, 3); MMA4(vA, pa[2]); MMA4(vB, pa[3]);
#pragma unroll
            for (int i_ = 0; i_ < 12; ++i_) { __builtin_amdgcn_sched_group_barrier(0x008, 1, 0); __builtin_amdgcn_sched_group_barrier(0x100, 2, 0); }
            __builtin_amdgcn_sched_group_barrier(0x008, 4, 0);
            SB();
        }
        if (t & 1) asm volatile("s_waitcnt lgkmcnt(0)\n\ts_barrier" ::: "memory");
    }
#undef VREAD
#undef MMA4
#undef SB
    lrun += __shfl_xor(lrun, 32);
    const float inv = 1.0f / lrun;
    LAS float* X = (LAS float*)lds;
    if (c == 1) {
        const float sc = inv * lam;
#pragma unroll
        for (int db = 0; db < 4; ++db)
#pragma unroll
            for (int r = 0; r < 16; ++r) X[(w * 64 + db * 16 + r) * 64 + lane] = o[db][r] * sc;
    }
    __syncthreads();
    if (c == 0) {
        float ss = 0.f;
#pragma unroll
        for (int db = 0; db < 4; ++db)
#pragma unroll
            for (int r = 0; r < 16; ++r) { const float d = o[db][r] * inv - X[(w * 64 + db * 16 + r) * 64 + lane]; o[db][r] = d; ss += d * d; }
        ss += __shfl_xor(ss, 32);
        const float rs = 0.8f / sqrtf(ss * (1.0f / 128.0f) + RMS_EPS);
        bf16* orow = ON + (seq0 + qpos) * DW + h * 128;
        f32x4 gsub[4][4];
#pragma unroll
        for (int db = 0; db < 4; ++db)
#pragma unroll
            for (int rg = 0; rg < 4; ++rg) gsub[db][rg] = *(const f32x4*)(subg + 32 * db + 8 * rg + 4 * hi);
        asm volatile("" ::: "memory");
#pragma unroll
        for (int db = 0; db < 4; ++db)
#pragma unroll
            for (int rg = 0; rg < 4; ++rg) { const int d0 = 32 * db + 8 * rg + 4 * hi; const f32x4 g = gsub[db][rg];
                v2u wv2; wv2.x = pk2(o[db][4 * rg] * rs * g.x, o[db][4 * rg + 1] * rs * g.y); wv2.y = pk2(o[db][4 * rg + 2] * rs * g.z, o[db][4 * rg + 3] * rs * g.w);
                *(v2u*)(orow + d0) = wv2; }
    }
    __syncthreads();
}
}

#define XB_TMO      128
#define XB_XCNT(j)  (256  + 64 * (j))
#define XB_XSUB(j)  (1280 + 64 * (j))
#define XB_XGEN(j)  (2304 + 64 * (j))
#define XB_TOP      3328
#define XB_TOPGEN   3392
#define XCD_BAR_WORDS 3456
#define XB_SPIN_CAP (1u << 18)

__device__ __forceinline__ unsigned xb_ld(unsigned* p)              { return __hip_atomic_load(p, __ATOMIC_RELAXED, __HIP_MEMORY_SCOPE_AGENT); }
__device__ __forceinline__ unsigned xb_add(unsigned* p, unsigned v) { return __hip_atomic_fetch_add(p, v, __ATOMIC_RELAXED, __HIP_MEMORY_SCOPE_AGENT); }
__device__ __forceinline__ unsigned xb_xcc_id() { return (unsigned)__builtin_amdgcn_s_getreg((3 << 11) | 20) & 0xFu; }
#define XB_SPIN(cond, bar) do { unsigned _sp = 0; while (cond) { __builtin_amdgcn_s_sleep(1); \
    if ((++_sp & 255u) == 0u) { if (xb_ld(&(bar)[XB_TMO])) break; if (_sp > XB_SPIN_CAP) { atomicAdd(&(bar)[XB_TMO], 1u); break; } } } } while (0)

struct XcdBarrier {
    unsigned* bar; unsigned x;
    volatile LAS unsigned* st;
};

__device__ __forceinline__ XcdBarrier xcd_barrier_post(unsigned* bar, volatile LAS unsigned* st) {
    XcdBarrier b; b.bar = bar; b.x = xb_xcc_id(); b.st = st;
    if (threadIdx.x == 0) (void)xb_add(&bar[XB_XCNT(b.x)], 1u);
    return b;
}
__device__ __forceinline__ void xcd_barrier_complete(unsigned* bar, unsigned x, unsigned& nloc, unsigned& nx) {
    const unsigned G = gridDim.x * gridDim.y * gridDim.z;
    unsigned sum, cnt, mine, sp = 0u;
    for (;;) {
        sum = 0u; cnt = 0u; mine = 0u;
#pragma unroll
        for (unsigned j = 0; j < 16; ++j) { const unsigned c = xb_ld(&bar[XB_XCNT(j)]); sum += c; cnt += (c > 0u) ? 1u : 0u; mine = (j == x) ? c : mine; }
        if (sum == G) break;
        __builtin_amdgcn_s_sleep(1);
        if ((++sp & 255u) == 0u) { if (xb_ld(&bar[XB_TMO])) break; if (sp > XB_SPIN_CAP) { atomicAdd(&bar[XB_TMO], 1u); break; } }
    }
    nloc = mine > 0u ? mine : 1u; nx = cnt > 0u ? cnt : 1u;
}

__device__ __forceinline__ void xcd_barrier(const XcdBarrier& b) {
    asm volatile("s_waitcnt vmcnt(0)" ::: "memory");
    __syncthreads();
    if (threadIdx.x == 0) {
        unsigned* bar = b.bar;
        __builtin_amdgcn_s_waitcnt(0);
        unsigned nloc = b.st[0], nx = b.st[1];
        if (nloc == 0u) { xcd_barrier_complete(bar, b.x, nloc, nx); b.st[0] = nloc; b.st[1] = nx; }
        const unsigned old = xb_add(&bar[XB_XSUB(b.x)], 1u);
        const unsigned gen = old / nloc;
        if (old + 1u == (gen + 1u) * nloc) {
            __builtin_amdgcn_fence(__ATOMIC_RELEASE, "agent");
            asm volatile("s_waitcnt vmcnt(0)" ::: "memory");
            const unsigned og = xb_add(&bar[XB_TOP], 1u);
            const unsigned tg = og / nx;
            if (og + 1u == (tg + 1u) * nx) xb_add(&bar[XB_TOPGEN], 1u);
            else XB_SPIN(xb_ld(&bar[XB_TOPGEN]) == tg, bar);
            __builtin_amdgcn_fence(__ATOMIC_ACQUIRE, "agent");
            xb_add(&bar[XB_XGEN(b.x)], 1u);
            asm volatile("s_waitcnt vmcnt(0)" ::: "memory");
        } else {
            XB_SPIN(xb_ld(&bar[XB_XGEN(b.x)]) == gen, bar);
            __builtin_amdgcn_fence(__ATOMIC_ACQUIRE, "agent");
            asm volatile("s_waitcnt vmcnt(0)" ::: "memory");
        }
    }
    __syncthreads();
}

struct Args { const float* in[17]; float* out; unsigned char* ws; int ph_lo, ph_hi; };
static_assert(sizeof(Args) == 17 * 8 + 8 + 8 + 8, "Args has no padding");

__global__ void __launch_bounds__(NWAVES * 64, 2) fwd_kernel(Args args) {
    extern __shared__ __attribute__((aligned(16))) unsigned char lds_raw[];
    LAS unsigned char* lds = (LAS unsigned char*)lds_raw;
    cg::grid_group grid = cg::this_grid();
    const int tid = threadIdx.x, lane = tid & 63, wave = __builtin_amdgcn_readfirstlane(tid >> 6);
    const int G = gridDim.x, bx = blockIdx.x;
    const int vcu = (G % 8 == 0) ? (bx % 8) * (G / 8) + bx / 8 : bx;
    unsigned char* ws = args.ws;
    const float* x = args.in[0]; const float* norm_mix_g = args.in[1]; const float* w_in = args.in[2]; const float* b_gate = args.in[3]; const float* conv_w = args.in[4];
    const float* lq1 = args.in[5]; const float* lk1 = args.in[6]; const float* lq2 = args.in[7]; const float* lk2 = args.in[8]; const float* subln_g = args.in[9];
    const float* w_a_out = args.in[10]; const float* w_b_out = args.in[11]; const float* w_o = args.in[12]; const float* norm_mlp_g = args.in[13];
    const float* w_mlp_in = args.in[14]; const float* w_mlp_out = args.in[15]; const float* norm_final_g = args.in[16];
    float* out = args.out;
    float* rss1 = (float*)(ws + WS_RSS1); float* rss2 = (float*)(ws + WS_RSS2);
    bf16 *Win = (bf16*)(ws + WS_WIN), *Wa = (bf16*)(ws + WS_WA), *Wb = (bf16*)(ws + WS_WB), *Wo = (bf16*)(ws + WS_WO), *Wmi = (bf16*)(ws + WS_WMI), *Wmo = (bf16*)(ws + WS_WMO);
    bf16 *XN = (bf16*)(ws + WS_XN), *UA = (bf16*)(ws + WS_UA), *UQ = (bf16*)(ws + WS_UQ), *GT = (bf16*)(ws + WS_GT), *CA = (bf16*)(ws + WS_CA), *ON = (bf16*)(ws + WS_ON);
    bf16 *MB = (bf16*)(ws + WS_MB), *TB = (bf16*)(ws + WS_TB), *HB = (bf16*)(ws + WS_HB);
    const int lo = args.ph_lo, hi = args.ph_hi;
    volatile LAS unsigned* MISC = (volatile LAS unsigned*)(lds + ATT_LDS + 512);
    if (tid < 2) MISC[tid] = 0u;
    __syncthreads();
    if (args.ph_lo < 0) grid.sync();
    const XcdBarrier bar = xcd_barrier_post((unsigned*)(ws + WS_BAR), MISC);
#define IN(k) (lo <= (k) && (k) < hi)
#define SEAM(k) do { if (IN(k) && IN((k) + 1)) { xcd_barrier(bar); } } while (0)

    if (IN(0)) _Pragma("unroll") for (int rep_ = 0; rep_ < REPS(0); ++rep_) {
        if (rep_) grid.sync();
        LAS float* scr = (LAS float*)(lds + wave * 16384);
        const int gw = vcu * NWAVES + wave, NGW = G * NWAVES;
        constexpr int I_IN = (D / 64) * (NIN / 32), I_A = (CW / 64) * (D / 32), I_B = I_A, I_O = (D / 64) * (D / 32), I_MI = (D / 64) * (FF / 32), I_MO = (FF / 64) * (D / 32);
        constexpr int NITEMS = I_IN + I_A + I_B + I_O + I_MI + I_MO;
        for (int it = gw; it < NITEMS; it += NGW) {
            int r = it;
            if (r < I_IN) { p0_transpose_item(w_in, nullptr, D, NIN, Win, scr, r, lane); continue; } r -= I_IN;
            if (r < I_A) { p0_transpose_item(w_a_out, nullptr, CW, D, Wa, scr, r, lane); continue; } r -= I_A;
            if (r < I_B) { p0_transpose_item(w_b_out, nullptr, DW, D, Wb, scr, r, lane); continue; } r -= I_B;
            if (r < I_O) { p0_transpose_item(w_o, nullptr, D, D, Wo, scr, r, lane); continue; } r -= I_O;
            if (r < I_MI) { p0_transpose_item(w_mlp_in, norm_mlp_g, D, FF, Wmi, scr, r, lane); continue; } r -= I_MI;
            p0_transpose_item(w_mlp_out, nullptr, FF, D, Wmo, scr, r, lane);
        }
        for (int m = gw; m < M; m += 2 * NGW) {
            if (m + NGW < M) rms_2rows_to_bf16(x + (size_t)m * D, x + (size_t)(m + NGW) * D, norm_mix_g, XN + (size_t)m * D, XN + (size_t)(m + NGW) * D, lane);
            else rms_row_to_bf16(x + (size_t)m * D, norm_mix_g, XN + (size_t)m * D, lane);
        }
        for (int i = bx * (NWAVES * 64) + tid; i < M; i += G * NWAVES * 64) { rss1[i] = 0.f; rss2[i] = 0.f; }
    }
    SEAM(0);

    if (IN(1)) _Pragma("unroll") for (int rep_ = 0; rep_ < REPS(1); ++rep_) {
        if (rep_) grid.sync();
        pg8::Gemm g{XN, Win, M, NIN, D}; pg8::StaticOrder S; S.init(M, NIN, G, bx);
        pg8::EpiIn E{UA, UQ, GT, b_gate, 0.125f * LOG2E};
        pg8::gemm_phase<pg8::EpiIn, pg8::StaticOrder, true, true>(lds, g, S, E);
    }
    SEAM(1);

    if (IN(2)) _Pragma("unroll") for (int rep_ = 0; rep_ < REPS(2); ++rep_) {
        if (rep_) grid.sync();
        float lam;
        { const float a = wave_sum(lq1[lane] * lk1[lane]), b2 = wave_sum(lq2[lane] * lk2[lane]); lam = expf(a) - expf(b2) + 0.2f; }
        if (rep_ == 0 || (PROBE_P2_PART & 1)) for (int p = vcu; p < 256; p += G) {
            const int bh = p >> 4, s = p & 15;
            att::unit(bh >> 2, bh & 3, 31 - s, UQ, ON, subln_g, lam, lds);
            att::unit(bh >> 2, bh & 3, s, UQ, ON, subln_g, lam, lds);
        }
        if (rep_ == 0 || (PROBE_P2_PART & 2)) for (int grp = (bx * (NWAVES * 64) + tid) >> 6; grp < M / 8; grp += (G * NWAVES * 64) >> 6) {
            const int t0 = grp * 8, ch = (tid & 63) * 8, ts0 = t0 & (SEQ - 1);
            const bf16* row = UA + (size_t)t0 * 1536 + ch;
            f32x4 wa[3], wb[3];
#pragma unroll
            for (int k = 0; k < 3; ++k) { wa[k] = *(const f32x4*)(conv_w + k * 512 + ch); wb[k] = *(const f32x4*)(conv_w + k * 512 + ch + 4); }
            v4u bgv[8], cgv[10], vav[10];
            cgv[0] = cgv[1] = vav[0] = vav[1] = (v4u){0, 0, 0, 0};
            if (ts0 != 0) { cgv[0] = *(const v4u*)(row - 3072 + 512); vav[0] = *(const v4u*)(row - 3072 + 1024); cgv[1] = *(const v4u*)(row - 1536 + 512); vav[1] = *(const v4u*)(row - 1536 + 1024); }
#pragma unroll
            for (int j = 0; j < 8; ++j) { bgv[j] = *(const v4u*)(row + j * 1536); cgv[j + 2] = *(const v4u*)(row + j * 1536 + 512); vav[j + 2] = *(const v4u*)(row + j * 1536 + 1024); }
            float hl[10][8];
#pragma unroll
            for (int j = 0; j < 10; ++j)
#pragma unroll
                for (int e = 0; e < 4; ++e) { hl[j][2 * e] = bflo(cgv[j][e]) * bflo(vav[j][e]); hl[j][2 * e + 1] = bfhi(cgv[j][e]) * bfhi(vav[j][e]); }
#pragma unroll
            for (int j = 0; j < 8; ++j) { v4u ov;
#pragma unroll
                for (int e = 0; e < 4; ++e) {
                    const float w0l = (e < 2) ? wa[0][2 * e] : wb[0][2 * e - 4], w0h = (e < 2) ? wa[0][2 * e + 1] : wb[0][2 * e - 3];
                    const float w1l = (e < 2) ? wa[1][2 * e] : wb[1][2 * e - 4], w1h = (e < 2) ? wa[1][2 * e + 1] : wb[1][2 * e - 3];
                    const float w2l = (e < 2) ? wa[2][2 * e] : wb[2][2 * e - 4], w2h = (e < 2) ? wa[2][2 * e + 1] : wb[2][2 * e - 3];
                    const float lo_ = bflo(bgv[j][e]) * (w0l * hl[j][2 * e] + w1l * hl[j + 1][2 * e] + w2l * hl[j + 2][2 * e]);
                    const float hi_ = bfhi(bgv[j][e]) * (w0h * hl[j][2 * e + 1] + w1h * hl[j + 1][2 * e + 1] + w2h * hl[j + 2][2 * e + 1]);
                    ov[e] = pk2(lo_, hi_); }
                *(v4u*)(CA + (size_t)(t0 + j) * CW + ch) = ov; }
        }
    }
    SEAM(2);

    if (IN(3)) {
        static_assert(WS_ON == WS_CA + (size_t)M * CW * 2 && WS_WB == WS_WA + (size_t)D * CW * 2, "P3 needs CA|ON and Wa|Wb stacked");
        pg8::Gemm g{CA, Wa, 2 * M, 2 * D, CW}; pg8::PairOrder S; S.init(M, D, G, bx);
        pg8::EpiGatePair E{GT, MB};
        pg8::gemm_phase<pg8::EpiGatePair, pg8::PairOrder, true, true>(lds, g, S, E);
    }
    SEAM(3);

    if (IN(4)) {
        pg8::Gemm g{MB, Wo, M, D, D}; pg8::StaticOrder S; S.init(M, D, G, bx);
        pg8::EpiRes<true, false, false> E{x, nullptr, nullptr, XN, rss1};
        pg8::gemm_phase<pg8::EpiRes<true, false, false>, pg8::StaticOrder, true, true>(lds, g, S, E);
    }
    SEAM(4);

    if (IN(5)) _Pragma("unroll") for (int rep_ = 0; rep_ < REPS(5); ++rep_) {
        if (rep_) grid.sync();
        pg8::Gemm g{XN, Wmi, M, FF, D}; pg8::StaticOrder S; S.init(M, FF, G, bx);
        pg8::EpiMlp E{HB, rss1, RMS_EPS};
        pg8::gemm_phase<pg8::EpiMlp, pg8::StaticOrder, true, true>(lds, g, S, E);
    }
    SEAM(5);

    const bool fuse_final = (G == 256) && IN(6) && IN(7);
    if (IN(6)) {
        pg8::Gemm g{HB, Wmo, M, D, FF}; pg8::StaticOrder S; S.init(M, D, G, bx);
        if (fuse_final) { pg8::EpiFinal E{XN, out, (float*)(ws + WS_SLOT), (unsigned*)(ws + WS_CNT), norm_final_g, RMS_EPS}; pg8::gemm_phase<pg8::EpiFinal, pg8::StaticOrder, true, true>(lds, g, S, E); }
        else { pg8::EpiRes<false, true, true> E{nullptr, XN, out, nullptr, rss2}; pg8::gemm_phase<pg8::EpiRes<false, true, true>, pg8::StaticOrder, true, true>(lds, g, S, E); }
    }
    if (!fuse_final) {
    SEAM(6);

    if (IN(7)) {
        const int gw = bx * NWAVES + wave, NGW = G * NWAVES;
        for (int m = gw; m < M; m += NGW) {
            const float rs = 1.0f / sqrtf(rss2[m] * (1.0f / D) + RMS_EPS);
            GAS f32x4* o = (GAS f32x4*)(out + (size_t)m * D) + lane; const GAS f32x4* gr = (const GAS f32x4*)norm_final_g + lane;
#pragma unroll
            for (int j = 0; j < 4; ++j) { const f32x4 v = o[64 * j], gg = gr[64 * j]; o[64 * j] = v * rs * gg; }
        }
    }
    }
#undef IN
#undef SEAM
}

extern "C" void kernel_launch(void* const* d_in, const int* in_sizes, int n_in, void* d_out, int out_size, void* d_ws, size_t ws_size, hipStream_t stream) {
    static int grid = 0;
    if (grid == 0) {
        if (n_in != 17 || out_size != M * D || ws_size < WS_END) { fprintf(stderr, "kernel_launch: unexpected shapes (n_in %d out %d ws %zu)\n", n_in, out_size, ws_size); grid = -1; return; }
        int dev = 0, cus = 0, per_cu = 0;
        if (hipGetDevice(&dev) != hipSuccess || hipDeviceGetAttribute(&cus, hipDeviceAttributeMultiprocessorCount, dev) != hipSuccess) { grid = -1; return; }
        if (hipFuncSetAttribute((const void*)fwd_kernel, hipFuncAttributeMaxDynamicSharedMemorySize, LDS_BYTES) != hipSuccess) { fprintf(stderr, "kernel_launch: hipFuncSetAttribute failed\n"); grid = -1; return; }
        if (hipOccupancyMaxActiveBlocksPerMultiprocessor(&per_cu, (const void*)fwd_kernel, NWAVES * 64, LDS_BYTES) != hipSuccess || per_cu < 1) per_cu = 1;
        (void)hipGetLastError();
        grid = cus * per_cu;
    }
    if (grid < 0) return;
    Args a{};
    for (int i = 0; i < 17; ++i) a.in[i] = (const float*)d_in[i];
    a.out = (float*)d_out; a.ws = (unsigned char*)d_ws;
#if MK_N_LAUNCHES == 1
    if (hipMemsetAsync((char*)d_ws + WS_BAR, 0, WS_BAR_BYTES, stream) != hipSuccess) { fprintf(stderr, "kernel_launch: memset of the barrier words failed\n"); return; }
    a.ph_lo = 0; a.ph_hi = N_PHASES;
    void* kargs[] = {&a};
    hipError_t e = hipLaunchCooperativeKernel((const void*)fwd_kernel, dim3(grid), dim3(NWAVES * 64), kargs, LDS_BYTES, stream);
    if (e != hipSuccess) fprintf(stderr, "kernel_launch: cooperative launch failed: %s (grid %d)\n", hipGetErrorString(e), grid);
#else
    for (int p = 0; p < N_PHASES; ++p) {
        a.ph_lo = p; a.ph_hi = p + 1;
        hipLaunchKernelGGL(fwd_kernel, dim3(grid), dim3(NWAVES * 64), LDS_BYTES, stream, a);
    }
#endif
}
```

```cpp
#include <hip/hip_runtime.h>
#include <hip/hip_cooperative_groups.h>
#include <cstdio>
#include <cstdint>
#include <cmath>
namespace cg = cooperative_groups;
namespace pg8 {
#define PG8_LAS __attribute__((address_space(3)))
typedef unsigned short bf16_t;
typedef short bf16x8 __attribute__((ext_vector_type(8)));
typedef float f32x4 __attribute__((ext_vector_type(4)));
typedef unsigned u32x4 __attribute__((ext_vector_type(4)));
constexpr int BM = 256, BK = 64, HALF = 128, HTB = HALF * BK * 2  , STAGE_BYTES = 8 * HTB, NXCD = 8, WGM = 8;

__host__ __device__ __forceinline__ int lds_byte(int r, int c) { const int st = (r >> 4) * 2 + (c >> 5), rr = r & 15, cc = c & 31, ob = rr * 64 + cc * 2; return st * 1024 + (ob ^ (((ob >> 9) & 1) << 5)); }
__host__ __device__ __forceinline__ void stage_rc(int b, int& R, int& C) { const int st = b / 1024, sb = b % 1024, swz = sb ^ (((sb >> 9) & 1) << 5); R = (st >> 1) * 16 + swz / 64; C = (st & 1) * 32 + (swz % 64) / 2; }
__host__ __device__ __forceinline__ int perm32(int rho) { const int n = rho >> 4, i = rho & 15; return 8 * (i >> 2) + 4 * n + (i & 3); }

struct Unit { int pm, pn; };
struct Gemm { const bf16_t* A; const bf16_t* Bt; int M, N, K; };

struct StaticOrder {
    int nM, nN, nwg, G, c;
    __host__ __device__ void init(int M, int N, int G_, int c_) { nM = M / BM; nN = N / BM; nwg = nM * nN; G = G_; c = c_; }
    __host__ __device__ bool next(int i, Unit& u) const {
        const long L = (long)i * G + c; if (L >= nwg) return false;
        int wgid = (int)L; { const int q = nwg / NXCD, r = nwg % NXCD, xcd = wgid % NXCD, off = wgid / NXCD; wgid = (xcd < r ? xcd * (q + 1) : r * (q + 1) + (xcd - r) * q) + off; }
        const int nig = WGM * nN, gid = wgid / nig, fm = gid * WGM, gsz = (nM - fm) < WGM ? (nM - fm) : WGM;
        u.pm = fm + ((wgid % nig) % gsz); u.pn = (wgid % nig) / gsz; return true;
    }
    __device__ __forceinline__ void a_ready(const Unit&) const {}
    __device__ __forceinline__ void done(const Unit&) const {}
};

__device__ __forceinline__ unsigned cvt_pk_bf16(float lo, float hi) { unsigned r; asm volatile("v_cvt_pk_bf16_f32 %0, %1, %2" : "=v"(r) : "v"(lo), "v"(hi)); return r; }
__device__ __forceinline__ float bf_lo(unsigned w) { return __uint_as_float(w << 16); }
__device__ __forceinline__ float bf_hi(unsigned w) { return __uint_as_float(w & 0xffff0000u); }
__device__ __forceinline__ float sigmoidf_fast(float v) { return __builtin_amdgcn_rcpf(1.0f + __builtin_amdgcn_exp2f(-1.4426950408889634f * v)); }


__device__ __forceinline__ u32x4 xpose16(u32x4 w, int srcaddr) {
    u32x4 r;
    r.x = (unsigned)__builtin_amdgcn_ds_bpermute(srcaddr, (int)w.x); r.y = (unsigned)__builtin_amdgcn_ds_bpermute(srcaddr, (int)w.y);
    r.z = (unsigned)__builtin_amdgcn_ds_bpermute(srcaddr, (int)w.z); r.w = (unsigned)__builtin_amdgcn_ds_bpermute(srcaddr, (int)w.w);
    return r;
}

struct EpiIn {
    static constexpr bool PERM = true, AFTER_DRAIN = false, CARRY = false;
    bf16_t* UA; bf16_t* UQ; bf16_t* GT; const float* bgate; float qscale;
    __device__ __forceinline__ void operator()(const f32x4 (&acc)[2][2][4][2], const Unit& u, int wr, int wc, int fr, int fq) const {
        const int row0 = u.pm * BM + wr * 64 + fr; const int ct = u.pn * BM;
        bf16_t* base; int colt, ldc, mode;
        if (ct < 1536) { base = UA; colt = ct; ldc = 1536; mode = 0; }
        else if (ct < 3072) { base = UQ; colt = ct - 1536; ldc = 1536; mode = (ct < 2048) ? 1 : 0; }
        else { base = GT; colt = ct - 3072; ldc = 2048; mode = 2; }
        const int col0 = colt + wc * 32 + 8 * fq;
        const int ln = threadIdx.x & 63, sfr = ln >> 2, sfq = ln & 3, srca = (sfr + 16 * sfq) * 4;
        const int srow0 = u.pm * BM + wr * 64 + sfr, scol0 = colt + wc * 32 + 8 * sfq;
        f32x4 bv[2][2];
#pragma unroll
        for (int bj = 0; bj < 2; ++bj)
#pragma unroll
            for (int n = 0; n < 2; ++n) bv[bj][n] = (mode == 2) ? *(const f32x4*)(bgate + col0 + bj * HALF + 4 * n) : (f32x4){0.f, 0.f, 0.f, 0.f};
        const float sc = (mode == 1) ? qscale : 1.0f;
#pragma unroll
        for (int ai = 0; ai < 2; ++ai)
#pragma unroll
            for (int m = 0; m < 4; ++m) { bf16_t* rowp = base + (size_t)(srow0 + ai * HALF + m * 16) * ldc + scol0;
#pragma unroll
                for (int bj = 0; bj < 2; ++bj) { f32x4 v0 = acc[ai][bj][m][0] + bv[bj][0], v1 = acc[ai][bj][m][1] + bv[bj][1];
                    if (mode == 2) {
#pragma unroll
                        for (int e = 0; e < 4; ++e) { v0[e] = sigmoidf_fast(v0[e]); v1[e] = sigmoidf_fast(v1[e]); }
                    }
                    v0 = v0 * sc; v1 = v1 * sc; u32x4 w; w.x = cvt_pk_bf16(v0[0], v0[1]); w.y = cvt_pk_bf16(v0[2], v0[3]); w.z = cvt_pk_bf16(v1[0], v1[1]); w.w = cvt_pk_bf16(v1[2], v1[3]);
                    *(u32x4*)(rowp + bj * HALF) = xpose16(w, srca); } }
    }
};

template <bool FIRST> struct EpiGate {
    static constexpr bool PERM = true, AFTER_DRAIN = false, CARRY = false;
    const bf16_t* GT; const bf16_t* Tin; bf16_t* O;
    __device__ __forceinline__ void operator()(const f32x4 (&acc)[2][2][4][2], const Unit& u, int wr, int wc, int fr, int fq) const {
        const int row0 = u.pm * BM + wr * 64 + fr; const int col0 = u.pn * BM + wc * 32 + 8 * fq;
#pragma unroll
        for (int ai = 0; ai < 2; ++ai)
#pragma unroll
            for (int m = 0; m < 4; ++m) { const size_t row = (size_t)(row0 + ai * HALF + m * 16);
#pragma unroll
                for (int bj = 0; bj < 2; ++bj) {
                    const u32x4 g = *(const u32x4*)(GT + row * 2048 + (FIRST ? 0 : 1024) + col0 + bj * HALF);
                    f32x4 v0 = acc[ai][bj][m][0], v1 = acc[ai][bj][m][1];
                    v0[0] *= bf_lo(g.x); v0[1] *= bf_hi(g.x); v0[2] *= bf_lo(g.y); v0[3] *= bf_hi(g.y);
                    v1[0] *= bf_lo(g.z); v1[1] *= bf_hi(g.z); v1[2] *= bf_lo(g.w); v1[3] *= bf_hi(g.w);
                    if (!FIRST) { const u32x4 t = *(const u32x4*)(Tin + row * 1024 + col0 + bj * HALF);
                        v0[0] += bf_lo(t.x); v0[1] += bf_hi(t.x); v0[2] += bf_lo(t.y); v0[3] += bf_hi(t.y);
                        v1[0] += bf_lo(t.z); v1[1] += bf_hi(t.z); v1[2] += bf_lo(t.w); v1[3] += bf_hi(t.w); }
                    u32x4 w; w.x = cvt_pk_bf16(v0[0], v0[1]); w.y = cvt_pk_bf16(v0[2], v0[3]); w.z = cvt_pk_bf16(v1[0], v1[1]); w.w = cvt_pk_bf16(v1[2], v1[3]);
                    *(u32x4*)(O + row * 1024 + col0 + bj * HALF) = w; } }
    }
};

template <bool WITH_BF16, bool F32OUT, bool BF16BASE> struct EpiRes {
    static constexpr bool PERM = false, AFTER_DRAIN = false, CARRY = false;
    const float* base; const bf16_t* baseb; float* out; bf16_t* ob; float* rowss;
    __device__ __forceinline__ void operator()(const f32x4 (&acc)[2][2][4][2], const Unit& u, int wr, int wc, int fr, int fq) const {
        typedef unsigned u32x2v __attribute__((ext_vector_type(2)));
        const int row0 = u.pm * BM + wr * 64 + fr; const int col0 = u.pn * BM + wc * 32 + 4 * fq;
#pragma unroll
        for (int ai = 0; ai < 2; ++ai)
#pragma unroll
            for (int m = 0; m < 4; ++m) { const int row = row0 + ai * HALF + m * 16; const size_t off = (size_t)row * 1024 + col0; float ss = 0.f;
#pragma unroll
                for (int bj = 0; bj < 2; ++bj)
#pragma unroll
                    for (int n = 0; n < 2; ++n) { f32x4 bs;
                        if (BF16BASE) { const u32x2v t = *(const u32x2v*)(baseb + off + bj * HALF + n * 16); bs = (f32x4){bf_lo(t.x), bf_hi(t.x), bf_lo(t.y), bf_hi(t.y)}; }
                        else bs = *(const f32x4*)(base + off + bj * HALF + n * 16);
                        const f32x4 v = bs + acc[ai][bj][m][n];
                        if (F32OUT) *(f32x4*)(out + off + bj * HALF + n * 16) = v;
                        ss += (v[0] * v[0] + v[1] * v[1]) + (v[2] * v[2] + v[3] * v[3]);
                        if (WITH_BF16) { u32x2v w; w.x = cvt_pk_bf16(v[0], v[1]); w.y = cvt_pk_bf16(v[2], v[3]); *(u32x2v*)(ob + off + bj * HALF + n * 16) = w; } }
                ss += __shfl_xor(ss, 16); ss += __shfl_xor(ss, 32);
                if (fq == 0) atomicAdd(rowss + row, ss); }
    }
};

struct EpiMlp {
    static constexpr bool PERM = true, AFTER_DRAIN = false, CARRY = false;
    bf16_t* O; const float* rowss; float eps;
    __device__ __forceinline__ void operator()(const f32x4 (&acc)[2][2][4][2], const Unit& u, int wr, int wc, int fr, int fq) const {
        const int row0 = u.pm * BM + wr * 64 + fr; const int col0 = u.pn * BM + wc * 32 + 8 * fq;
        const int ln = threadIdx.x & 63, sfr = ln >> 2, sfq = ln & 3, srca = (sfr + 16 * sfq) * 4;
        const int srow0 = u.pm * BM + wr * 64 + sfr, scol0 = u.pn * BM + wc * 32 + 8 * sfq;
#pragma unroll
        for (int ai = 0; ai < 2; ++ai)
#pragma unroll
            for (int m = 0; m < 4; ++m) { const int row = row0 + ai * HALF + m * 16; const float rs = __builtin_amdgcn_rsqf(rowss[row] * (1.0f / 1024.0f) + eps);
                bf16_t* rowp = O + (size_t)(srow0 + ai * HALF + m * 16) * 4096 + scol0;
#pragma unroll
                for (int bj = 0; bj < 2; ++bj) { f32x4 v0 = acc[ai][bj][m][0] * rs, v1 = acc[ai][bj][m][1] * rs;
#pragma unroll
                    for (int e = 0; e < 4; ++e) { const float a = fmaxf(v0[e], 0.f), b = fmaxf(v1[e], 0.f); v0[e] = a * a; v1[e] = b * b; }
                    u32x4 w; w.x = cvt_pk_bf16(v0[0], v0[1]); w.y = cvt_pk_bf16(v0[2], v0[3]); w.z = cvt_pk_bf16(v1[0], v1[1]); w.w = cvt_pk_bf16(v1[2], v1[3]);
                    *(u32x4*)(rowp + bj * HALF) = xpose16(w, srca); } }
    }
};

struct EpiFinal {
    static constexpr bool PERM = false, AFTER_DRAIN = false, CARRY = false;
    const bf16_t* base; float* out; float* rowss; unsigned* cnt; const float* gfin; float eps;
    __device__ __forceinline__ void operator()(f32x4 (&acc)[2][2][4][2], const Unit& u, int wr, int wc, int fr, int fq) const {
        const int row0 = u.pm * BM + wr * 64 + fr; const int col0 = u.pn * BM + wc * 32 + 4 * fq;
#pragma unroll
        for (int ai = 0; ai < 2; ++ai)
#pragma unroll
            for (int m = 0; m < 4; ++m) { const int row = row0 + ai * HALF + m * 16; const size_t off = (size_t)row * 1024 + col0; float ss = 0.f;
#pragma unroll
                for (int bj = 0; bj < 2; ++bj)
#pragma unroll
                    for (int n = 0; n < 2; ++n) { typedef unsigned u32x2v __attribute__((ext_vector_type(2))); const u32x2v t = *(const u32x2v*)(base + off + bj * HALF + n * 16);
                        const f32x4 v = (f32x4){bf_lo(t.x), bf_hi(t.x), bf_lo(t.y), bf_hi(t.y)} + acc[ai][bj][m][n];
                        acc[ai][bj][m][n] = v; ss += (v[0] * v[0] + v[1] * v[1]) + (v[2] * v[2] + v[3] * v[3]); }
                ss += __shfl_xor(ss, 16); ss += __shfl_xor(ss, 32);
                if (fq == 0) __hip_atomic_store(rowss + (size_t)row * 16 + u.pn * 4 + wc, ss, __ATOMIC_RELAXED, __HIP_MEMORY_SCOPE_AGENT); }
        asm volatile("s_waitcnt vmcnt(0)" ::: "memory");
        unsigned* c = cnt + 64 * u.pm;
        if ((threadIdx.x & 63) == 0) __hip_atomic_fetch_add(c, 1u, __ATOMIC_RELAXED, __HIP_MEMORY_SCOPE_AGENT);
        { unsigned sp = 0;
          while ((unsigned)__builtin_amdgcn_readfirstlane(__hip_atomic_load(c, __ATOMIC_RELAXED, __HIP_MEMORY_SCOPE_AGENT)) < 32u) { __builtin_amdgcn_s_sleep(2); if (++sp > (1u << 22)) break; } }
        asm volatile("" ::: "memory");
#pragma unroll
        for (int ai = 0; ai < 2; ++ai)
#pragma unroll
            for (int m = 0; m < 4; ++m) { const int row = row0 + ai * HALF + m * 16; const size_t off = (size_t)row * 1024 + col0;
                float tot = 0.f;
#pragma unroll
                for (int e = 0; e < 4; ++e) tot += __hip_atomic_load(rowss + (size_t)row * 16 + 4 * fq + e, __ATOMIC_RELAXED, __HIP_MEMORY_SCOPE_AGENT);
                tot += __shfl_xor(tot, 16); tot += __shfl_xor(tot, 32);
                const float rs = __builtin_amdgcn_rsqf(tot * (1.0f / 1024.0f) + eps);
#pragma unroll
                for (int bj = 0; bj < 2; ++bj)
#pragma unroll
                    for (int n = 0; n < 2; ++n) { const f32x4 g = *(const f32x4*)(gfin + col0 + bj * HALF + n * 16);
                        *(f32x4*)(out + off + bj * HALF + n * 16) = acc[ai][bj][m][n] * rs * g; } }
    }
};

struct EpiGatePair {
    static constexpr bool PERM = true, AFTER_DRAIN = false, CARRY = true;
    const bf16_t* GT; bf16_t* O;
    __device__ __forceinline__ void operator()(f32x4 (&acc)[2][2][4][2], const Unit& u, int wr, int wc, int fr, int fq) const {
        const bool second = (u.pm >= 64);
        const int row0 = (u.pm & 63) * BM + wr * 64 + fr; const int col0 = (u.pn & 3) * BM + wc * 32 + 8 * fq;
#pragma unroll
        for (int ai = 0; ai < 2; ++ai)
#pragma unroll
            for (int m = 0; m < 4; ++m) { const size_t row = (size_t)(row0 + ai * HALF + m * 16);
#pragma unroll
                for (int bj = 0; bj < 2; ++bj) {
                    const u32x4 gb = *(const u32x4*)(GT + row * 2048 + 1024 + col0 + bj * HALF);
                    f32x4 v0 = acc[ai][bj][m][0], v1 = acc[ai][bj][m][1];
                    if (!second) {
                        const u32x4 ga = *(const u32x4*)(GT + row * 2048 + col0 + bj * HALF);
                        v0[0] *= bf_lo(ga.x) * __builtin_amdgcn_rcpf(bf_lo(gb.x)); v0[1] *= bf_hi(ga.x) * __builtin_amdgcn_rcpf(bf_hi(gb.x)); v0[2] *= bf_lo(ga.y) * __builtin_amdgcn_rcpf(bf_lo(gb.y)); v0[3] *= bf_hi(ga.y) * __builtin_amdgcn_rcpf(bf_hi(gb.y));
                        v1[0] *= bf_lo(ga.z) * __builtin_amdgcn_rcpf(bf_lo(gb.z)); v1[1] *= bf_hi(ga.z) * __builtin_amdgcn_rcpf(bf_hi(gb.z)); v1[2] *= bf_lo(ga.w) * __builtin_amdgcn_rcpf(bf_lo(gb.w)); v1[3] *= bf_hi(ga.w) * __builtin_amdgcn_rcpf(bf_hi(gb.w));
                        acc[ai][bj][m][0] = v0; acc[ai][bj][m][1] = v1;
                    } else {
                        v0[0] *= bf_lo(gb.x); v0[1] *= bf_hi(gb.x); v0[2] *= bf_lo(gb.y); v0[3] *= bf_hi(gb.y);
                        v1[0] *= bf_lo(gb.z); v1[1] *= bf_hi(gb.z); v1[2] *= bf_lo(gb.w); v1[3] *= bf_hi(gb.w);
                        u32x4 w; w.x = cvt_pk_bf16(v0[0], v0[1]); w.y = cvt_pk_bf16(v0[2], v0[3]); w.z = cvt_pk_bf16(v1[0], v1[1]); w.w = cvt_pk_bf16(v1[2], v1[3]);
                        *(u32x4*)(O + row * 1024 + col0 + bj * HALF) = w;
                        acc[ai][bj][m][0] = (f32x4){0.f, 0.f, 0.f, 0.f}; acc[ai][bj][m][1] = (f32x4){0.f, 0.f, 0.f, 0.f};
                    } } }
    }
};
struct PairOrder {
    StaticOrder so;
    __host__ __device__ void init(int M, int N, int G_, int c_) { so.init(M, N, G_, c_); }
    __host__ __device__ bool next(int i, Unit& u) const { if (!so.next(i >> 1, u)) return false; if (i & 1) { u.pm += 64; u.pn += 4; } return true; }
    __device__ __forceinline__ void a_ready(const Unit&) const {}
    __device__ __forceinline__ void done(const Unit&) const {}
};

template <class Epi, class Sched, bool ALIGN_EPI = false, bool SP2 = false>
__device__ __forceinline__ void gemm_phase(PG8_LAS unsigned char* lds, const Gemm g, const Sched& S, const Epi& E) {
    const int tid = threadIdx.x, wid = __builtin_amdgcn_readfirstlane(tid >> 6), lane = tid & 63, wr = wid >> 2, wc = wid & 3, fr = lane & 15, fq = lane >> 4;
    const int K = g.K, nt = K / BK;
    unsigned voffA[2], voffB[2];
#pragma unroll
    for (int i = 0; i < 2; ++i) { int R, C; stage_rc(tid * 16 + i * 8192, R, C); const int Rb = Epi::PERM ? ((R & ~31) + perm32(R & 31)) : R;
        voffA[i] = (unsigned)(R * K + C) * 2u; voffB[i] = (unsigned)(Rb * K + C) * 2u; }
    const size_t kstep = (size_t)(BK * 2);
    const size_t hstep = (size_t)HALF * K * 2;
    const size_t tstep = 2 * hstep;
    const unsigned ldsw = (unsigned)wid * 1024u;
    const int aoff = lds_byte(wr * 64 + fr, fq * 8), boff = lds_byte(wc * 32 + fr, fq * 8);
#define PG8_SA(b, h) (((b) * 2 + (h)) * HTB)
#define PG8_SB(b, h) ((4 + (b) * 2 + (h)) * HTB)
#define PG8_STAGE(bufoff, gbase, voff) do { _Pragma("unroll") for (int _i = 0; _i < 2; ++_i) \
        __builtin_amdgcn_global_load_lds((const unsigned*)((const char*)(gbase) + (voff)[_i]), (PG8_LAS unsigned*)(lds + (bufoff) + ldsw + _i * 8192), 16, 0, 0); } while (0)
#define PG8_LDA(dst, b, h) do { _Pragma("unroll") for (int m = 0; m < 4; ++m) _Pragma("unroll") for (int k = 0; k < 2; ++k) dst[m][k] = *(const PG8_LAS bf16x8*)(lds + PG8_SA(b, h) + aoff + m * 2048 + k * 1024); } while (0)
#define PG8_LDB(dst, b, h) do { _Pragma("unroll") for (int n = 0; n < 2; ++n) _Pragma("unroll") for (int k = 0; k < 2; ++k) dst[n][k] = *(const PG8_LAS bf16x8*)(lds + PG8_SB(b, h) + boff + n * 2048 + k * 1024); } while (0)
#define PG8_MMA(ai, bj, At, Bt) do { __builtin_amdgcn_s_setprio(1); _Pragma("unroll") for (int m = 0; m < 4; ++m) _Pragma("unroll") for (int n = 0; n < 2; ++n) _Pragma("unroll") for (int k = 0; k < 2; ++k) \
        acc[ai][bj][m][n] = __builtin_amdgcn_mfma_f32_16x16x32_bf16(Bt[n][k], At[m][k], acc[ai][bj][m][n], 0, 0, 0); __builtin_amdgcn_s_setprio(0); } while (0)
#define PG8_WAIT_V(n) asm volatile("s_waitcnt vmcnt(" #n ")" ::: "memory")
#define PG8_WAIT_L(n) asm volatile("s_waitcnt lgkmcnt(" #n ")" ::: "memory")
#define PG8_BAR __builtin_amdgcn_s_barrier()
#define PG8_SCHED __builtin_amdgcn_sched_barrier(0)
    Unit cur, nxt; int ui = 0;
    if (!S.next(0, cur)) return;
    f32x4 acc[2][2][4][2];
#pragma unroll
    for (int a = 0; a < 2; ++a)
#pragma unroll
        for (int b = 0; b < 2; ++b)
#pragma unroll
            for (int m = 0; m < 4; ++m)
#pragma unroll
                for (int n = 0; n < 2; ++n) acc[a][b][m][n] = (f32x4){0.f, 0.f, 0.f, 0.f};
    bf16x8 At[4][2], B0[2][2], B1[2][2];
    const char* cA = (const char*)g.A + (size_t)cur.pm * tstep; const char* cB = (const char*)g.Bt + (size_t)cur.pn * tstep;
    S.a_ready(cur);
    if constexpr (SP2) {
        PG8_STAGE(PG8_SB(0, 0), cB, voffB); PG8_STAGE(PG8_SB(0, 1), cB + hstep, voffB); PG8_STAGE(PG8_SA(0, 0), cA, voffA); PG8_STAGE(PG8_SA(0, 1), cA + hstep, voffA);
        if (wr == 1) PG8_BAR;
        PG8_WAIT_V(2); PG8_BAR;
        PG8_STAGE(PG8_SB(1, 0), cB + kstep, voffB); PG8_STAGE(PG8_SA(1, 0), cA + kstep, voffA); PG8_STAGE(PG8_SB(1, 1), cB + hstep + kstep, voffB);
        PG8_WAIT_V(6); PG8_BAR;
    } else {
        PG8_STAGE(PG8_SB(0, 0), cB, voffB); PG8_STAGE(PG8_SA(0, 0), cA, voffA); PG8_STAGE(PG8_SB(0, 1), cB + hstep, voffB); PG8_STAGE(PG8_SA(0, 1), cA + hstep, voffA);
        if (wr == 1) PG8_BAR;
        PG8_WAIT_V(4); PG8_BAR;
        PG8_STAGE(PG8_SB(1, 0), cB + kstep, voffB); PG8_STAGE(PG8_SA(1, 0), cA + kstep, voffA); PG8_STAGE(PG8_SB(1, 1), cB + hstep + kstep, voffB);
        PG8_WAIT_V(6); PG8_BAR;
    }
    for (;;) {
        const bool has_next = S.next(ui + 1, nxt);
        const char* nA = has_next ? (const char*)g.A + (size_t)nxt.pm * tstep : cA; const char* nB = has_next ? (const char*)g.Bt + (size_t)nxt.pn * tstep : cB;
        for (int t = 0; t < nt; t += 2) {
            const bool last = (t == nt - 2);
            const char* a1 = cA + (size_t)(t + 1) * kstep;
            const char* a2 = last ? nA : cA + (size_t)(t + 2) * kstep; const char* b2 = last ? nB : cB + (size_t)(t + 2) * kstep;
            const char* a3 = a2 + kstep; const char* b3 = b2 + kstep;
            if (last && has_next) S.a_ready(nxt);
            if constexpr (SP2) {
            PG8_LDB(B0, 0, 0); PG8_LDB(B1, 0, 1); PG8_SCHED; PG8_LDA(At, 0, 0); PG8_STAGE(PG8_SA(1, 1), a1 + hstep, voffA);
            PG8_WAIT_V(8); PG8_WAIT_L(0); PG8_BAR; PG8_MMA(0, 0, At, B0); PG8_MMA(0, 1, At, B1); PG8_BAR; PG8_SCHED;
            PG8_LDA(At, 0, 1); PG8_STAGE(PG8_SB(0, 0), b2, voffB); PG8_STAGE(PG8_SB(0, 1), b2 + hstep, voffB); PG8_STAGE(PG8_SA(0, 0), a2, voffA);
            PG8_WAIT_V(8); PG8_WAIT_L(0); PG8_BAR; PG8_MMA(1, 0, At, B0); PG8_MMA(1, 1, At, B1); PG8_BAR; PG8_SCHED;
            PG8_LDB(B0, 1, 0); PG8_LDB(B1, 1, 1); PG8_SCHED; PG8_LDA(At, 1, 0); PG8_STAGE(PG8_SA(0, 1), a2 + hstep, voffA);
            PG8_WAIT_V(8); PG8_WAIT_L(0); PG8_BAR; PG8_MMA(0, 0, At, B0); PG8_MMA(0, 1, At, B1); PG8_BAR; PG8_SCHED;
            PG8_LDA(At, 1, 1); PG8_STAGE(PG8_SB(1, 0), b3, voffB); PG8_STAGE(PG8_SB(1, 1), b3 + hstep, voffB); PG8_STAGE(PG8_SA(1, 0), a3, voffA);
            PG8_WAIT_V(8); PG8_WAIT_L(0); PG8_BAR; PG8_MMA(1, 0, At, B0); PG8_MMA(1, 1, At, B1); PG8_BAR; PG8_SCHED;
            } else {
            PG8_LDB(B0, 0, 0); PG8_SCHED; PG8_LDA(At, 0, 0); PG8_STAGE(PG8_SA(1, 1), a1 + hstep, voffA);
            PG8_WAIT_L(8); PG8_BAR; PG8_WAIT_L(0); PG8_MMA(0, 0, At, B0); PG8_BAR; PG8_SCHED;
            PG8_LDB(B1, 0, 1); PG8_STAGE(PG8_SB(0, 0), b2, voffB);
            PG8_BAR; PG8_WAIT_L(0); PG8_MMA(0, 1, At, B1); PG8_BAR;
            PG8_LDA(At, 0, 1); PG8_STAGE(PG8_SA(0, 0), a2, voffA);
            PG8_BAR; PG8_WAIT_L(0); PG8_MMA(1, 0, At, B0); PG8_BAR; PG8_SCHED;
            PG8_STAGE(PG8_SB(0, 1), b2 + hstep, voffB);
            PG8_WAIT_V(6); PG8_BAR; PG8_MMA(1, 1, At, B1); PG8_BAR;
            PG8_LDB(B0, 1, 0); PG8_SCHED; PG8_LDA(At, 1, 0); PG8_STAGE(PG8_SA(0, 1), a2 + hstep, voffA);
            PG8_WAIT_L(8); PG8_BAR; PG8_WAIT_L(0); PG8_MMA(0, 0, At, B0); PG8_BAR; PG8_SCHED;
            PG8_LDB(B1, 1, 1); PG8_STAGE(PG8_SB(1, 0), b3, voffB);
            PG8_BAR; PG8_WAIT_L(0); PG8_MMA(0, 1, At, B1); PG8_BAR;
            PG8_LDA(At, 1, 1); PG8_STAGE(PG8_SA(1, 0), a3, voffA);
            PG8_BAR; PG8_WAIT_L(0); PG8_MMA(1, 0, At, B0); PG8_BAR; PG8_SCHED;
            PG8_STAGE(PG8_SB(1, 1), b3 + hstep, voffB);
            PG8_WAIT_V(6); PG8_BAR; PG8_MMA(1, 1, At, B1); PG8_BAR;
            }
        }
        if constexpr (ALIGN_EPI) { if (wr == 0) PG8_BAR; }
        if constexpr (!Epi::AFTER_DRAIN) { E(acc, cur, wr, wc, fr, fq); S.done(cur); }
        if (!has_next) break;
        if constexpr (!Epi::CARRY)
#pragma unroll
        for (int a = 0; a < 2; ++a)
#pragma unroll
            for (int b = 0; b < 2; ++b)
#pragma unroll
                for (int m = 0; m < 4; ++m)
#pragma unroll
                    for (int n = 0; n < 2; ++n) acc[a][b][m][n] = (f32x4){0.f, 0.f, 0.f, 0.f};
        cur = nxt; cA = nA; cB = nB; ++ui;
        if constexpr (ALIGN_EPI) { if (wr == 1) PG8_BAR; }
    }
    PG8_WAIT_V(0);
    if constexpr (!ALIGN_EPI) { if (wr == 0) PG8_BAR; }
    PG8_BAR;
    if constexpr (Epi::AFTER_DRAIN) { E.fused(acc, cur, wr, wc, fr, fq, lds, wid, lane); S.done(cur); }
#undef PG8_SA
#undef PG8_SB
#undef PG8_STAGE
#undef PG8_LDA
#undef PG8_LDB
#undef PG8_MMA
#undef PG8_WAIT_V
#undef PG8_WAIT_L
#undef PG8_BAR
#undef PG8_SCHED
}
}

constexpr int NWAVES = 8;
constexpr int BATCH = 4, SEQ = 4096, D = 1024, M = BATCH * SEQ, NIN = 5120, FF = 4096, CW = 512, DW = 512, NH = 4;
constexpr float RMS_EPS = 1e-6f;
constexpr float LOG2E = 1.4426950408889634f;
#ifndef MK_N_LAUNCHES
#define MK_N_LAUNCHES 1
#endif
constexpr int N_PHASES = 8;
#ifndef PROBE_P2_PART
#define PROBE_P2_PART 3
#endif
#ifndef PROBE_DUP_MASK
#define PROBE_DUP_MASK 0
#endif
#define REPS(k) (1 + ((PROBE_DUP_MASK >> (k)) & 1))

constexpr size_t MiB = 1u << 20;
constexpr size_t WS_RSS1 = 0, WS_RSS2 = 65536;
constexpr size_t WS_BAR = 131072, WS_CNT = WS_BAR + 16384, WS_BAR_BYTES = 49152;
constexpr size_t WS_WIN = 1 * MiB;
constexpr size_t WS_WA = 11 * MiB, WS_WB = 12 * MiB;
constexpr size_t WS_WO = 13 * MiB;
constexpr size_t WS_WMI = 15 * MiB;
constexpr size_t WS_WMO = 23 * MiB;
constexpr size_t WS_SLOT = 31 * MiB;
constexpr size_t WS_XN = 32 * MiB;
constexpr size_t WS_UA = 64 * MiB;
constexpr size_t WS_UQ = 112 * MiB;
constexpr size_t WS_GT = 160 * MiB;
constexpr size_t WS_CA = 224 * MiB;
constexpr size_t WS_ON = 240 * MiB;
constexpr size_t WS_MB = 64 * MiB;
constexpr size_t WS_TB = 96 * MiB;
constexpr size_t WS_HB = 64 * MiB;
constexpr size_t WS_END = 256 * MiB;

constexpr int RING_BYTES = 131072;
constexpr int ATT_LDS = 4 * 38912;
constexpr int LDS_BYTES = ATT_LDS + 1024;

#define GAS __attribute__((address_space(1)))
#define LAS __attribute__((address_space(3)))
typedef unsigned short bf16;
typedef unsigned v4u __attribute__((ext_vector_type(4)));
typedef unsigned v2u __attribute__((ext_vector_type(2)));
typedef float f32x4 __attribute__((ext_vector_type(4)));
typedef float f32x16 __attribute__((ext_vector_type(16)));
typedef short bf16x8 __attribute__((ext_vector_type(8)));
typedef short s16x4 __attribute__((ext_vector_type(4)));
#define LDS_WAIT() asm volatile("s_waitcnt lgkmcnt(0)" ::: "memory")
__device__ __forceinline__ unsigned f2bf(float f) { unsigned u = __builtin_bit_cast(unsigned, f); return (u + 0x7fffu + ((u >> 16) & 1u)) >> 16; }
__device__ __forceinline__ unsigned pk2(float lo, float hi) { return f2bf(lo) | (f2bf(hi) << 16); }
__device__ __forceinline__ float bflo(unsigned w) { return __uint_as_float(w << 16); }
__device__ __forceinline__ float bfhi(unsigned w) { return __uint_as_float(w & 0xffff0000u); }
__device__ __forceinline__ float wave_sum(float v) {
#pragma unroll
    for (int o = 1; o < 64; o <<= 1) v += __shfl_xor(v, o);
    return v;
}

__device__ __forceinline__ void p0_transpose_item(const float* W, const float* gain, int K, int N, bf16* WT, LAS float* scr, int item, int lane) {
    const int nblk = N / 32, kb = item / nblk, nb = item % nblk, k0 = 64 * kb, n0 = 32 * nb;
    float wv_[32];
#pragma unroll
    for (int i = 0; i < 32; ++i) { const int kk = 2 * i + (lane >> 5); wv_[i] = W[(size_t)(k0 + kk) * N + n0 + (lane & 31)]; }
    if (gain) {
#pragma unroll
        for (int i = 0; i < 32; ++i) wv_[i] *= gain[k0 + 2 * i + (lane >> 5)];
    }
#pragma unroll
    for (int i = 0; i < 32; ++i) { const int kk = 2 * i + (lane >> 5); scr[kk * 33 + (lane & 31)] = wv_[i]; }
    LDS_WAIT(); asm volatile("" ::: "memory");
    const int c = lane & 7;
#pragma unroll
    for (int j = 0; j < 4; ++j) { const int n = (lane >> 3) + 8 * j; const LAS float* s = scr + (8 * c) * 33 + n;
        v4u o; o.x = pk2(s[0 * 33], s[1 * 33]); o.y = pk2(s[2 * 33], s[3 * 33]); o.z = pk2(s[4 * 33], s[5 * 33]); o.w = pk2(s[6 * 33], s[7 * 33]);
        *(GAS v4u*)(WT + (size_t)(n0 + n) * K + k0 + 8 * c) = o; }
    LDS_WAIT(); asm volatile("" ::: "memory");
}
__device__ __forceinline__ void rms_row_to_bf16(const float* xrow, const float* g, bf16* orow, int lane) {
    const GAS f32x4* xr = (const GAS f32x4*)xrow + lane; const GAS f32x4* gr = (const GAS f32x4*)g + lane;
    f32x4 v[4]; float s2 = 0.f;
#pragma unroll
    for (int j = 0; j < 4; ++j) { v[j] = xr[64 * j]; s2 += (v[j].x * v[j].x + v[j].y * v[j].y) + (v[j].z * v[j].z + v[j].w * v[j].w); }
    const float rstd = 1.f / sqrtf(wave_sum(s2) * (1.f / D) + RMS_EPS);
    GAS unsigned long long* o8 = (GAS unsigned long long*)orow + lane;
#pragma unroll
    for (int j = 0; j < 4; ++j) { const f32x4 gg = gr[64 * j];
        o8[64 * j] = (unsigned long long)pk2(v[j].x * rstd * gg.x, v[j].y * rstd * gg.y) | ((unsigned long long)pk2(v[j].z * rstd * gg.z, v[j].w * rstd * gg.w) << 32); }
}

__device__ __forceinline__ void rms_2rows_to_bf16(const float* xa, const float* xb, const float* g, bf16* oa, bf16* ob, int lane) {
    const GAS f32x4* xra = (const GAS f32x4*)xa + lane; const GAS f32x4* xrb = (const GAS f32x4*)xb + lane; const GAS f32x4* gr = (const GAS f32x4*)g + lane;
    f32x4 va[4], vb[4]; float sa = 0.f, sb = 0.f;
#pragma unroll
    for (int j = 0; j < 4; ++j) { va[j] = xra[64 * j]; vb[j] = xrb[64 * j]; }
#pragma unroll
    for (int j = 0; j < 4; ++j) { sa += (va[j].x * va[j].x + va[j].y * va[j].y) + (va[j].z * va[j].z + va[j].w * va[j].w); sb += (vb[j].x * vb[j].x + vb[j].y * vb[j].y) + (vb[j].z * vb[j].z + vb[j].w * vb[j].w); }
    const float ra = 1.f / sqrtf(wave_sum(sa) * (1.f / D) + RMS_EPS), rb = 1.f / sqrtf(wave_sum(sb) * (1.f / D) + RMS_EPS);
    GAS unsigned long long* o8a = (GAS unsigned long long*)oa + lane; GAS unsigned long long* o8b = (GAS unsigned long long*)ob + lane;
#pragma unroll
    for (int j = 0; j < 4; ++j) { const f32x4 gg = gr[64 * j];
        o8a[64 * j] = (unsigned long long)pk2(va[j].x * ra * gg.x, va[j].y * ra * gg.y) | ((unsigned long long)pk2(va[j].z * ra * gg.z, va[j].w * ra * gg.w) << 32);
        o8b[64 * j] = (unsigned long long)pk2(vb[j].x * rb * gg.x, vb[j].y * rb * gg.y) | ((unsigned long long)pk2(vb[j].z * rb * gg.z, vb[j].w * rb * gg.w) << 32); }
}

namespace att {
constexpr int PITCH = 1536;
constexpr int KROW = 144, VROW = 320;
constexpr int K0_OFF = 0, K1_OFF = 64 * KROW, V_OFF = 2 * 64 * KROW, STAGE = V_OFF + 64 * VROW;
static_assert(4 * STAGE == ATT_LDS && 65536 <= 2 * STAGE, "attention LDS map");
__device__ __forceinline__ int crow(int r, int hi) { return (r & 3) + 8 * (r >> 2) + 4 * hi; }
__device__ __forceinline__ unsigned cvtpk(float lo, float hi) { unsigned r; asm volatile("v_cvt_pk_bf16_f32 %0, %1, %2" : "=v"(r) : "v"(lo), "v"(hi)); return r; }
__device__ __forceinline__ float max3f(float a, float b, float c) { float r; asm("v_max3_f32 %0, %1, %2, %3" : "=v"(r) : "v"(a), "v"(b), "v"(c)); return r; }
typedef float f32x2a_t __attribute__((ext_vector_type(2))); typedef __bf16 bf16x2a_t __attribute__((ext_vector_type(2)));
__device__ __forceinline__ unsigned cvtpk_c(float lo, float hi) { f32x2a_t v = {lo, hi}; bf16x2a_t b = __builtin_convertvector(v, bf16x2a_t); return __builtin_bit_cast(unsigned, b); }
__device__ __forceinline__ s16x4 vtr(LAS const unsigned char* p) { return __builtin_bit_cast(s16x4, __builtin_amdgcn_ds_read_tr16_b64_v4i16((LAS s16x4*)p)); }

__device__ __forceinline__ void unit(int b, int h, int qb, const bf16* UQ, bf16* ON, const float* subg, float lam, LAS unsigned char* lds) {
    const int tid = threadIdx.x, lane = tid & 63, r32 = lane & 31, hi = lane >> 5;
    const int wid = __builtin_amdgcn_readfirstlane(tid >> 6), c = wid >> 2, w = wid & 3;
    const size_t seq0 = (size_t)b * SEQ;
    const int qw0 = 128 * qb + 32 * w, qpos = qw0 + r32;
    const float slope2 = exp2f(-2.0f * (float)(h + 1)) * LOG2E;
    int tidl = tid; asm volatile("" : "+v"(tidl));
    const int krow = tidl >> 3, kch = tidl & 7, vrow = tidl >> 4, vch = tidl & 15;
    const bf16* gk = UQ + (seq0 + krow) * PITCH + 512 + h * 128 + kch * 8;
    const bf16* gv = UQ + (seq0 + vrow) * PITCH + 1024 + h * 128 + vch * 8;
    const unsigned wk = krow * KROW + kch * 16, wv = V_OFF + vrow * VROW + vch * 16;
    LAS const unsigned char* kbase = lds + (c ? K1_OFF : K0_OFF) + r32 * KROW + hi * 16;
    const int gi = lane & 15;
    LAS const unsigned char* vbase = lds + V_OFF + (4 * hi + (gi >> 2)) * VROW + (16 * ((lane >> 4) & 1) + 4 * (gi & 3)) * 2;
    bf16x8 qf[4];
    { const bf16* qp = UQ + (seq0 + qpos) * PITCH + h * 128 + c * 64 + hi * 8;
#pragma unroll
      for (int s = 0; s < 4; ++s) qf[s] = *(const bf16x8*)(qp + 16 * s); }
    asm volatile("" : "+v"(qf[0]), "+v"(qf[1]), "+v"(qf[2]), "+v"(qf[3]));
    f32x16 o[4];
#pragma unroll
    for (int db = 0; db < 4; ++db)
#pragma unroll
        for (int r = 0; r < 16; ++r) o[db][r] = 0.f;
    float mref = 0.f, lrun = 0.f;
    constexpr float THR = 60.0f;
    const int NT = 2 * (qb + 1);
    v4u sk0, sk1, sv0, sv1;
    sk0 = *(const v4u*)gk; sk1 = *(const v4u*)(gk + 64); sv0 = *(const v4u*)gv; sv1 = *(const v4u*)(gv + 32 * PITCH);
    *(LAS v4u*)(lds + K0_OFF + wk) = sk0; *(LAS v4u*)(lds + K1_OFF + wk) = sk1; *(LAS v4u*)(lds + wv) = sv0; *(LAS v4u*)(lds + wv + 32 * VROW) = sv1;
    asm volatile("" : "+v"(qf[0]), "+v"(qf[1]), "+v"(qf[2]), "+v"(qf[3]));
    { const size_t go = (size_t)64 * PITCH; sk0 = *(const v4u*)(gk + go); sk1 = *(const v4u*)(gk + go + 64); sv0 = *(const v4u*)(gv + go); sv1 = *(const v4u*)(gv + go + 32 * PITCH); }
    *(LAS v4u*)(lds + STAGE + K0_OFF + wk) = sk0; *(LAS v4u*)(lds + STAGE + K1_OFF + wk) = sk1; *(LAS v4u*)(lds + STAGE + wv) = sv0; *(LAS v4u*)(lds + STAGE + wv + 32 * VROW) = sv1;
    if (NT > 2) { const size_t go = (size_t)128 * PITCH; sk0 = *(const v4u*)(gk + go); sk1 = *(const v4u*)(gk + go + 64); sv0 = *(const v4u*)(gv + go); sv1 = *(const v4u*)(gv + go + 32 * PITCH); }
    asm volatile("s_waitcnt lgkmcnt(0)\n\ts_barrier" ::: "memory");
#define VREAD(dst, kk) do { _Pragma("unroll") for (int db_ = 0; db_ < 4; ++db_) { LAS const unsigned char* vp_ = vbase + boff + (16 * (kk)) * VROW + db_ * 64; \
        const s16x4 lo_ = vtr(vp_), hh_ = vtr(vp_ + 8 * VROW); dst[db_] = (bf16x8){lo_[0], lo_[1], lo_[2], lo_[3], hh_[0], hh_[1], hh_[2], hh_[3]}; } } while (0)
#define MMA4(vv, pp) do { _Pragma("unroll") for (int db_ = 0; db_ < 4; ++db_) o[db_] = __builtin_amdgcn_mfma_f32_32x32x16_bf16(vv[db_], pp, o[db_], 0, 0, 0); } while (0)
#define SB() __builtin_amdgcn_sched_barrier(0)
    for (int t = 0; t < NT; ++t) {
        const int boff = (t & 3) * STAGE;
        if (t + 2 < NT) { const int nb = ((t + 2) & 3) * STAGE;
            *(LAS v4u*)(lds + nb + K0_OFF + wk) = sk0; *(LAS v4u*)(lds + nb + K1_OFF + wk) = sk1; *(LAS v4u*)(lds + nb + wv) = sv0; *(LAS v4u*)(lds + nb + wv + 32 * VROW) = sv1; }
        if (t + 3 < NT) { const size_t go = (size_t)(t + 3) * 64 * PITCH;
            sk0 = *(const v4u*)(gk + go); sk1 = *(const v4u*)(gk + go + 64); sv0 = *(const v4u*)(gv + go); sv1 = *(const v4u*)(gv + go + 32 * PITCH); }
        const int kt0 = 64 * t;
        if (kt0 <= qw0 + 31) {
            f32x16 p0, p1;
            { const float base0 = fmaf(slope2, (float)(kt0 - qpos + 4 * hi), -mref), base1 = base0 + 32.0f * slope2;
#pragma unroll
              for (int r = 0; r < 16; ++r) { const float cr = (float)((r & 3) + 8 * (r >> 2)); p0[r] = fmaf(slope2, cr, base0); p1[r] = fmaf(slope2, cr, base1); } }
#pragma unroll
            for (int s = 0; s < 4; ++s) {
                const bf16x8 k0f = *(LAS const bf16x8*)(kbase + boff + s * 32);
                const bf16x8 k1f = *(LAS const bf16x8*)(kbase + boff + 32 * KROW + s * 32);
                p0 = __builtin_amdgcn_mfma_f32_32x32x16_bf16(k0f, qf[s], p0, 0, 0, 0);
                p1 = __builtin_amdgcn_mfma_f32_32x32x16_bf16(k1f, qf[s], p1, 0, 0, 0);
            }
            bf16x8 vA[4], vB[4];
            VREAD(vA, 0); SB();
            if (kt0 + 63 > qw0) {
#pragma unroll
                for (int r = 0; r < 16; ++r) { const int kv = kt0 + crow(r, hi); if (kv > qpos) p0[r] = -INFINITY; if (kv + 32 > qpos) p1[r] = -INFINITY; }
            }
            asm volatile("s_nop 15\n\ts_nop 3" : "+v"(p0), "+v"(p1));
            float mx = max3f(p0[0], p1[0], p0[1]), mx2 = max3f(p1[1], p0[2], p1[2]);
#pragma unroll
            for (int r = 3; r < 15; r += 2) { mx = max3f(mx, p0[r], p1[r]); mx2 = max3f(mx2, p0[r + 1], p1[r + 1]); }
            mx = max3f(mx, p0[15], p1[15]);
            mx = max3f(mx, mx2, __shfl_xor(fmaxf(mx, mx2), 32));
            if (t == 0 || __any(mx > THR)) {
                const float dl = (t == 0) ? mx : fmaxf(mx, 0.f);
                mref += dl;
                const float f = (t == 0) ? 1.0f : __builtin_amdgcn_exp2f(-dl);
                lrun *= f;
#pragma unroll
                for (int r = 0; r < 16; ++r) { p0[r] -= dl; p1[r] -= dl; }
#pragma unroll
                for (int db = 0; db < 4; ++db)
#pragma unroll
                    for (int r = 0; r < 16; ++r) o[db][r] *= f;
            }
            bf16x8 pa[4];
#pragma unroll
            for (int r = 0; r < 16; ++r) p0[r] = __builtin_amdgcn_exp2f(p0[r]);
            { v4u x;
              x.x = cvtpk_c(p0[0], p0[1]); x.y = cvtpk_c(p0[2], p0[3]); x.z = cvtpk_c(p0[4], p0[5]); x.w = cvtpk_c(p0[6], p0[7]); pa[0] = __builtin_bit_cast(bf16x8, x);
              x.x = cvtpk_c(p0[8], p0[9]); x.y = cvtpk_c(p0[10], p0[11]); x.z = cvtpk_c(p0[12], p0[13]); x.w = cvtpk_c(p0[14], p0[15]); pa[1] = __builtin_bit_cast(bf16x8, x); }
            SB();
#pragma unroll
            for (int r = 0; r < 16; ++r) p1[r] = __builtin_amdgcn_exp2f(p1[r]);
            { v4u x;
              x.x = cvtpk_c(p1[0], p1[1]); x.y = cvtpk_c(p1[2], p1[3]); x.z = cvtpk_c(p1[4], p1[5]); x.w = cvtpk_c(p1[6], p1[7]); pa[2] = __builtin_bit_cast(bf16x8, x);
              x.x = cvtpk_c(p1[8], p1[9]); x.y = cvtpk_c(p1[10], p1[11]); x.z = cvtpk_c(p1[12], p1[13]); x.w = cvtpk_c(p1[14], p1[15]); pa[3] = __builtin_bit_cast(bf16x8, x); }
            float ls = 0.f;
#pragma unroll
            for (int r = 0; r < 16; ++r) { ls += p0[r]; ls += p1[r]; }
            lrun += ls;
            VREAD(vB, 1); MMA4(vA, pa[0]); VREAD(vA, 2); MMA4(vB, pa[1]); VREAD(vB, 3); MMA4(vA, pa[2]); MMA4(vB, pa[3]);
#pragma unroll
            for (int i_ = 0; i_ < 8; ++i_) { __builtin_amdgcn_sched_group_barrier(0x008, 1, 0); __builtin_amdgcn_sched_group_barrier(0x100, 2, 0); __builtin_amdgcn_sched_group_barrier(0x400, 2, 0); __builtin_amdgcn_sched_group_barrier(0x002, 2, 0); }
#pragma unroll
            for (int i_ = 0; i_ < 4; ++i_) { __builtin_amdgcn_sched_group_barrier(0x008, 1, 0); __builtin_amdgcn_sched_group_barrier(0x100, 2, 0); __builtin_amdgcn_sched_group_barrier(0x002, 3, 0); }
#pragma unroll
            for (int i_ = 0; i_ < 4; ++i_) { __builtin_amdgcn_sched_group_barrier(0x008, 1, 0); __builtin_amdgcn_sched_group_barrier(0x002, 3, 0); }
            SB();
        }
        if (t & 1) asm volatile("s_waitcnt lgkmcnt(0)\n\ts_barrier" ::: "memory");
    }
#undef VREAD
#undef MMA4
#undef SB
    lrun += __shfl_xor(lrun, 32);
    const float inv = 1.0f / lrun;
    LAS float* X = (LAS float*)lds;
    if (c == 1) {
        const float sc = inv * lam;
#pragma unroll
        for (int db = 0; db < 4; ++db)
#pragma unroll
            for (int r = 0; r < 16; ++r) X[(w * 64 + db * 16 + r) * 64 + lane] = o[db][r] * sc;
    }
    __syncthreads();
    if (c == 0) {
        float ss = 0.f;
#pragma unroll
        for (int db = 0; db < 4; ++db)
#pragma unroll
            for (int r = 0; r < 16; ++r) { const float d = o[db][r] * inv - X[(w * 64 + db * 16 + r) * 64 + lane]; o[db][r] = d; ss += d * d; }
        ss += __shfl_xor(ss, 32);
        const float rs = 0.8f / sqrtf(ss * (1.0f / 128.0f) + RMS_EPS);
        bf16* orow = ON + (seq0 + qpos) * DW + h * 128;
        f32x4 gsub[4][4];
#pragma unroll
        for (int db = 0; db < 4; ++db)
#pragma unroll
            for (int rg = 0; rg < 4; ++rg) gsub[db][rg] = *(const f32x4*)(subg + 32 * db + 8 * rg + 4 * hi);
        asm volatile("" ::: "memory");
#pragma unroll
        for (int db = 0; db < 4; ++db)
#pragma unroll
            for (int rg = 0; rg < 4; ++rg) { const int d0 = 32 * db + 8 * rg + 4 * hi; const f32x4 g = gsub[db][rg];
                v2u wv2; wv2.x = pk2(o[db][4 * rg] * rs * g.x, o[db][4 * rg + 1] * rs * g.y); wv2.y = pk2(o[db][4 * rg + 2] * rs * g.z, o[db][4 * rg + 3] * rs * g.w);
                *(v2u*)(orow + d0) = wv2; }
    }
    __syncthreads();
}
}

#define XB_TMO      128
#define XB_XCNT(j)  (256  + 64 * (j))
#define XB_XSUB(j)  (1280 + 64 * (j))
#define XB_XGEN(j)  (2304 + 64 * (j))
#define XB_TOP      3328
#define XB_TOPGEN   3392
#define XCD_BAR_WORDS 3456
#define XB_SPIN_CAP (1u << 18)

__device__ __forceinline__ unsigned xb_ld(unsigned* p)              { return __hip_atomic_load(p, __ATOMIC_RELAXED, __HIP_MEMORY_SCOPE_AGENT); }
__device__ __forceinline__ unsigned xb_add(unsigned* p, unsigned v) { return __hip_atomic_fetch_add(p, v, __ATOMIC_RELAXED, __HIP_MEMORY_SCOPE_AGENT); }
__device__ __forceinline__ unsigned xb_xcc_id() { return (unsigned)__builtin_amdgcn_s_getreg((3 << 11) | 20) & 0xFu; }
#define XB_SPIN(cond, bar) do { unsigned _sp = 0; while (cond) { __builtin_amdgcn_s_sleep(1); \
    if ((++_sp & 255u) == 0u) { if (xb_ld(&(bar)[XB_TMO])) break; if (_sp > XB_SPIN_CAP) { atomicAdd(&(bar)[XB_TMO], 1u); break; } } } } while (0)

struct XcdBarrier {
    unsigned* bar; unsigned x;
    volatile LAS unsigned* st;
};

__device__ __forceinline__ XcdBarrier xcd_barrier_post(unsigned* bar, volatile LAS unsigned* st) {
    XcdBarrier b; b.bar = bar; b.x = xb_xcc_id(); b.st = st;
    if (threadIdx.x == 0) (void)xb_add(&bar[XB_XCNT(b.x)], 1u);
    return b;
}
__device__ __forceinline__ void xcd_barrier_complete(unsigned* bar, unsigned x, unsigned& nloc, unsigned& nx) {
    const unsigned G = gridDim.x * gridDim.y * gridDim.z;
    unsigned sum, cnt, mine, sp = 0u;
    for (;;) {
        sum = 0u; cnt = 0u; mine = 0u;
#pragma unroll
        for (unsigned j = 0; j < 16; ++j) { const unsigned c = xb_ld(&bar[XB_XCNT(j)]); sum += c; cnt += (c > 0u) ? 1u : 0u; mine = (j == x) ? c : mine; }
        if (sum == G) break;
        __builtin_amdgcn_s_sleep(1);
        if ((++sp & 255u) == 0u) { if (xb_ld(&bar[XB_TMO])) break; if (sp > XB_SPIN_CAP) { atomicAdd(&bar[XB_TMO], 1u); break; } }
    }
    nloc = mine > 0u ? mine : 1u; nx = cnt > 0u ? cnt : 1u;
}

__device__ __forceinline__ void xcd_barrier(const XcdBarrier& b) {
    asm volatile("s_waitcnt vmcnt(0)" ::: "memory");
    __syncthreads();
    if (threadIdx.x == 0) {
        unsigned* bar = b.bar;
        __builtin_amdgcn_s_waitcnt(0);
        unsigned nloc = b.st[0], nx = b.st[1];
        if (nloc == 0u) { xcd_barrier_complete(bar, b.x, nloc, nx); b.st[0] = nloc; b.st[1] = nx; }
        const unsigned old = xb_add(&bar[XB_XSUB(b.x)], 1u);
        const unsigned gen = old / nloc;
        if (old + 1u == (gen + 1u) * nloc) {
            __builtin_amdgcn_fence(__ATOMIC_RELEASE, "agent");
            asm volatile("s_waitcnt vmcnt(0)" ::: "memory");
            const unsigned og = xb_add(&bar[XB_TOP], 1u);
            const unsigned tg = og / nx;
            if (og + 1u == (tg + 1u) * nx) xb_add(&bar[XB_TOPGEN], 1u);
            else XB_SPIN(xb_ld(&bar[XB_TOPGEN]) == tg, bar);
            __builtin_amdgcn_fence(__ATOMIC_ACQUIRE, "agent");
            xb_add(&bar[XB_XGEN(b.x)], 1u);
            asm volatile("s_waitcnt vmcnt(0)" ::: "memory");
        } else {
            XB_SPIN(xb_ld(&bar[XB_XGEN(b.x)]) == gen, bar);
            __builtin_amdgcn_fence(__ATOMIC_ACQUIRE, "agent");
            asm volatile("s_waitcnt vmcnt(0)" ::: "memory");
        }
    }
    __syncthreads();
}

struct Args { const float* in[17]; float* out; unsigned char* ws; int ph_lo, ph_hi; };
static_assert(sizeof(Args) == 17 * 8 + 8 + 8 + 8, "Args has no padding");

__global__ void __launch_bounds__(NWAVES * 64, 2) fwd_kernel(Args args) {
    extern __shared__ __attribute__((aligned(16))) unsigned char lds_raw[];
    LAS unsigned char* lds = (LAS unsigned char*)lds_raw;
    cg::grid_group grid = cg::this_grid();
    const int tid = threadIdx.x, lane = tid & 63, wave = __builtin_amdgcn_readfirstlane(tid >> 6);
    const int G = gridDim.x, bx = blockIdx.x;
    const int vcu = (G % 8 == 0) ? (bx % 8) * (G / 8) + bx / 8 : bx;
    unsigned char* ws = args.ws;
    const float* x = args.in[0]; const float* norm_mix_g = args.in[1]; const float* w_in = args.in[2]; const float* b_gate = args.in[3]; const float* conv_w = args.in[4];
    const float* lq1 = args.in[5]; const float* lk1 = args.in[6]; const float* lq2 = args.in[7]; const float* lk2 = args.in[8]; const float* subln_g = args.in[9];
    const float* w_a_out = args.in[10]; const float* w_b_out = args.in[11]; const float* w_o = args.in[12]; const float* norm_mlp_g = args.in[13];
    const float* w_mlp_in = args.in[14]; const float* w_mlp_out = args.in[15]; const float* norm_final_g = args.in[16];
    float* out = args.out;
    float* rss1 = (float*)(ws + WS_RSS1); float* rss2 = (float*)(ws + WS_RSS2);
    bf16 *Win = (bf16*)(ws + WS_WIN), *Wa = (bf16*)(ws + WS_WA), *Wb = (bf16*)(ws + WS_WB), *Wo = (bf16*)(ws + WS_WO), *Wmi = (bf16*)(ws + WS_WMI), *Wmo = (bf16*)(ws + WS_WMO);
    bf16 *XN = (bf16*)(ws + WS_XN), *UA = (bf16*)(ws + WS_UA), *UQ = (bf16*)(ws + WS_UQ), *GT = (bf16*)(ws + WS_GT), *CA = (bf16*)(ws + WS_CA), *ON = (bf16*)(ws + WS_ON);
    bf16 *MB = (bf16*)(ws + WS_MB), *TB = (bf16*)(ws + WS_TB), *HB = (bf16*)(ws + WS_HB);
    const int lo = args.ph_lo, hi = args.ph_hi;
    volatile LAS unsigned* MISC = (volatile LAS unsigned*)(lds + ATT_LDS + 512);
    if (tid < 2) MISC[tid] = 0u;
    __syncthreads();
    if (args.ph_lo < 0) grid.sync();
    const XcdBarrier bar = xcd_barrier_post((unsigned*)(ws + WS_BAR), MISC);
#define IN(k) (lo <= (k) && (k) < hi)
#define SEAM(k) do { if (IN(k) && IN((k) + 1)) { xcd_barrier(bar); } } while (0)

    if (IN(0)) _Pragma("unroll") for (int rep_ = 0; rep_ < REPS(0); ++rep_) {
        if (rep_) grid.sync();
        LAS float* scr = (LAS float*)(lds + wave * 16384);
        const int gw = vcu * NWAVES + wave, NGW = G * NWAVES;
        constexpr int I_IN = (D / 64) * (NIN / 32), I_A = (CW / 64) * (D / 32), I_B = I_A, I_O = (D / 64) * (D / 32), I_MI = (D / 64) * (FF / 32), I_MO = (FF / 64) * (D / 32);
        constexpr int NITEMS = I_IN + I_A + I_B + I_O + I_MI + I_MO;
        for (int it = gw; it < NITEMS; it += NGW) {
            int r = it;
            if (r < I_IN) { p0_transpose_item(w_in, nullptr, D, NIN, Win, scr, r, lane); continue; } r -= I_IN;
            if (r < I_A) { p0_transpose_item(w_a_out, nullptr, CW, D, Wa, scr, r, lane); continue; } r -= I_A;
            if (r < I_B) { p0_transpose_item(w_b_out, nullptr, DW, D, Wb, scr, r, lane); continue; } r -= I_B;
            if (r < I_O) { p0_transpose_item(w_o, nullptr, D, D, Wo, scr, r, lane); continue; } r -= I_O;
            if (r < I_MI) { p0_transpose_item(w_mlp_in, norm_mlp_g, D, FF, Wmi, scr, r, lane); continue; } r -= I_MI;
            p0_transpose_item(w_mlp_out, nullptr, FF, D, Wmo, scr, r, lane);
        }
        for (int m = gw; m < M; m += 2 * NGW) {
            if (m + NGW < M) rms_2rows_to_bf16(x + (size_t)m * D, x + (size_t)(m + NGW) * D, norm_mix_g, XN + (size_t)m * D, XN + (size_t)(m + NGW) * D, lane);
            else rms_row_to_bf16(x + (size_t)m * D, norm_mix_g, XN + (size_t)m * D, lane);
        }
        for (int i = bx * (NWAVES * 64) + tid; i < M; i += G * NWAVES * 64) { rss1[i] = 0.f; rss2[i] = 0.f; }
    }
    SEAM(0);

    if (IN(1)) _Pragma("unroll") for (int rep_ = 0; rep_ < REPS(1); ++rep_) {
        if (rep_) grid.sync();
        pg8::Gemm g{XN, Win, M, NIN, D}; pg8::StaticOrder S; S.init(M, NIN, G, bx);
        pg8::EpiIn E{UA, UQ, GT, b_gate, 0.125f * LOG2E};
        pg8::gemm_phase<pg8::EpiIn, pg8::StaticOrder, true, true>(lds, g, S, E);
    }
    SEAM(1);

    if (IN(2)) _Pragma("unroll") for (int rep_ = 0; rep_ < REPS(2); ++rep_) {
        if (rep_) grid.sync();
        float lam;
        { const float a = wave_sum(lq1[lane] * lk1[lane]), b2 = wave_sum(lq2[lane] * lk2[lane]); lam = expf(a) - expf(b2) + 0.2f; }
        if (rep_ == 0 || (PROBE_P2_PART & 1)) for (int p = vcu; p < 256; p += G) {
            const int bh = p >> 4, s = p & 15;
            att::unit(bh >> 2, bh & 3, 31 - s, UQ, ON, subln_g, lam, lds);
            att::unit(bh >> 2, bh & 3, s, UQ, ON, subln_g, lam, lds);
        }
        if (rep_ == 0 || (PROBE_P2_PART & 2)) for (int grp = (bx * (NWAVES * 64) + tid) >> 6; grp < M / 8; grp += (G * NWAVES * 64) >> 6) {
            const int t0 = grp * 8, ch = (tid & 63) * 8, ts0 = t0 & (SEQ - 1);
            const bf16* row = UA + (size_t)t0 * 1536 + ch;
            f32x4 wa[3], wb[3];
#pragma unroll
            for (int k = 0; k < 3; ++k) { wa[k] = *(const f32x4*)(conv_w + k * 512 + ch); wb[k] = *(const f32x4*)(conv_w + k * 512 + ch + 4); }
            v4u bgv[8], cgv[10], vav[10];
            cgv[0] = cgv[1] = vav[0] = vav[1] = (v4u){0, 0, 0, 0};
            if (ts0 != 0) { cgv[0] = *(const v4u*)(row - 3072 + 512); vav[0] = *(const v4u*)(row - 3072 + 1024); cgv[1] = *(const v4u*)(row - 1536 + 512); vav[1] = *(const v4u*)(row - 1536 + 1024); }
#pragma unroll
            for (int j = 0; j < 8; ++j) { bgv[j] = *(const v4u*)(row + j * 1536); cgv[j + 2] = *(const v4u*)(row + j * 1536 + 512); vav[j + 2] = *(const v4u*)(row + j * 1536 + 1024); }
            float hl[10][8];
#pragma unroll
            for (int j = 0; j < 10; ++j)
#pragma unroll
                for (int e = 0; e < 4; ++e) { hl[j][2 * e] = bflo(cgv[j][e]) * bflo(vav[j][e]); hl[j][2 * e + 1] = bfhi(cgv[j][e]) * bfhi(vav[j][e]); }
#pragma unroll
            for (int j = 0; j < 8; ++j) { v4u ov;
#pragma unroll
                for (int e = 0; e < 4; ++e) {
                    const float w0l = (e < 2) ? wa[0][2 * e] : wb[0][2 * e - 4], w0h = (e < 2) ? wa[0][2 * e + 1] : wb[0][2 * e - 3];
                    const float w1l = (e < 2) ? wa[1][2 * e] : wb[1][2 * e - 4], w1h = (e < 2) ? wa[1][2 * e + 1] : wb[1][2 * e - 3];
                    const float w2l = (e < 2) ? wa[2][2 * e] : wb[2][2 * e - 4], w2h = (e < 2) ? wa[2][2 * e + 1] : wb[2][2 * e - 3];
                    const float lo_ = bflo(bgv[j][e]) * (w0l * hl[j][2 * e] + w1l * hl[j + 1][2 * e] + w2l * hl[j + 2][2 * e]);
                    const float hi_ = bfhi(bgv[j][e]) * (w0h * hl[j][2 * e + 1] + w1h * hl[j + 1][2 * e + 1] + w2h * hl[j + 2][2 * e + 1]);
                    ov[e] = pk2(lo_, hi_); }
                *(v4u*)(CA + (size_t)(t0 + j) * CW + ch) = ov; }
        }
    }
    SEAM(2);

    if (IN(3)) {
        static_assert(WS_ON == WS_CA + (size_t)M * CW * 2 && WS_WB == WS_WA + (size_t)D * CW * 2, "P3 needs CA|ON and Wa|Wb stacked");
        pg8::Gemm g{CA, Wa, 2 * M, 2 * D, CW}; pg8::PairOrder S; S.init(M, D, G, bx);
        pg8::EpiGatePair E{GT, MB};
        pg8::gemm_phase<pg8::EpiGatePair, pg8::PairOrder, true, true>(lds, g, S, E);
    }
    SEAM(3);

    if (IN(4)) {
        pg8::Gemm g{MB, Wo, M, D, D}; pg8::StaticOrder S; S.init(M, D, G, bx);
        pg8::EpiRes<true, false, false> E{x, nullptr, nullptr, XN, rss1};
        pg8::gemm_phase<pg8::EpiRes<true, false, false>, pg8::StaticOrder, true, true>(lds, g, S, E);
    }
    SEAM(4);

    if (IN(5)) _Pragma("unroll") for (int rep_ = 0; rep_ < REPS(5); ++rep_) {
        if (rep_) grid.sync();
        pg8::Gemm g{XN, Wmi, M, FF, D}; pg8::StaticOrder S; S.init(M, FF, G, bx);
        pg8::EpiMlp E{HB, rss1, RMS_EPS};
        pg8::gemm_phase<pg8::EpiMlp, pg8::StaticOrder, true, true>(lds, g, S, E);
    }
    SEAM(5);

    const bool fuse_final = (G == 256) && IN(6) && IN(7);
    if (IN(6)) {
        pg8::Gemm g{HB, Wmo, M, D, FF}; pg8::StaticOrder S; S.init(M, D, G, bx);
        if (fuse_final) { pg8::EpiFinal E{XN, out, (float*)(ws + WS_SLOT), (unsigned*)(ws + WS_CNT), norm_final_g, RMS_EPS}; pg8::gemm_phase<pg8::EpiFinal, pg8::StaticOrder, true, true>(lds, g, S, E); }
        else { pg8::EpiRes<false, true, true> E{nullptr, XN, out, nullptr, rss2}; pg8::gemm_phase<pg8::EpiRes<false, true, true>, pg8::StaticOrder, true, true>(lds, g, S, E); }
    }
    if (!fuse_final) {
    SEAM(6);

    if (IN(7)) {
        const int gw = bx * NWAVES + wave, NGW = G * NWAVES;
        for (int m = gw; m < M; m += NGW) {
            const float rs = 1.0f / sqrtf(rss2[m] * (1.0f / D) + RMS_EPS);
            GAS f32x4* o = (GAS f32x4*)(out + (size_t)m * D) + lane; const GAS f32x4* gr = (const GAS f32x4*)norm_final_g + lane;
#pragma unroll
            for (int j = 0; j < 4; ++j) { const f32x4 v = o[64 * j], gg = gr[64 * j]; o[64 * j] = v * rs * gg; }
        }
    }
    }
#undef IN
#undef SEAM
}

extern "C" void kernel_launch(void* const* d_in, const int* in_sizes, int n_in, void* d_out, int out_size, void* d_ws, size_t ws_size, hipStream_t stream) {
    static int grid = 0;
    if (grid == 0) {
        if (n_in != 17 || out_size != M * D || ws_size < WS_END) { fprintf(stderr, "kernel_launch: unexpected shapes (n_in %d out %d ws %zu)\n", n_in, out_size, ws_size); grid = -1; return; }
        int dev = 0, cus = 0, per_cu = 0;
        if (hipGetDevice(&dev) != hipSuccess || hipDeviceGetAttribute(&cus, hipDeviceAttributeMultiprocessorCount, dev) != hipSuccess) { grid = -1; return; }
        if (hipFuncSetAttribute((const void*)fwd_kernel, hipFuncAttributeMaxDynamicSharedMemorySize, LDS_BYTES) != hipSuccess) { fprintf(stderr, "kernel_launch: hipFuncSetAttribute failed\n"); grid = -1; return; }
        if (hipOccupancyMaxActiveBlocksPerMultiprocessor(&per_cu, (const void*)fwd_kernel, NWAVES * 64, LDS_BYTES) != hipSuccess || per_cu < 1) per_cu = 1;
        (void)hipGetLastError();
        grid = cus * per_cu;
    }
    if (grid < 0) return;
    Args a{};
    for (int i = 0; i < 17; ++i) a.in[i] = (const float*)d_in[i];
    a.out = (float*)d_out; a.ws = (unsigned char*)d_ws;
#if MK_N_LAUNCHES == 1
    if (hipMemsetAsync((char*)d_ws + WS_BAR, 0, WS_BAR_BYTES, stream) != hipSuccess) { fprintf(stderr, "kernel_launch: memset of the barrier words failed\n"); return; }
    a.ph_lo = 0; a.ph_hi = N_PHASES;
    void* kargs[] = {&a};
    hipError_t e = hipLaunchCooperativeKernel((const void*)fwd_kernel, dim3(grid), dim3(NWAVES * 64), kargs, LDS_BYTES, stream);
    if (e != hipSuccess) fprintf(stderr, "kernel_launch: cooperative launch failed: %s (grid %d)\n", hipGetErrorString(e), grid);
#else
    for (int p = 0; p < N_PHASES; ++p) {
        a.ph_lo = p; a.ph_hi = p + 1;
        hipLaunchKernelGGL(fwd_kernel, dim3(grid), dim3(NWAVES * 64), LDS_BYTES, stream, a);
    }
#endif
}
```
